# Optimizing an MI355X kernel written in HIP

```python
import jax, jax.numpy as jnp
from jax import lax
import numpy as np

D_MODEL = 1024
BATCH = 8
SEQ = 4096
DEPTH = 1

CHUNK = 64
SGU_BLOCK = 128
SGU_WIDTH = 1024
SGU_GROUPS = 8
SGU_GROUP_DIM = SGU_WIDTH // SGU_GROUPS
HGRN_WIDTH = 1024
HGRN_EXPAND = 128
HGRN_HEADS = HGRN_WIDTH // HGRN_EXPAND
N_BRANCH = 2
D_FF = 2816
CONV_WIDTH = 3
PLE_DIM = 256
LN_EPS = 1e-5
RMS_EPS = 1e-6
ALPHA = (2 * DEPTH) ** 0.25
BETA = (8 * DEPTH) ** -0.25
IN_COLS = 2 * SGU_WIDTH + 4 * HGRN_WIDTH + N_BRANCH * D_MODEL

kernel_name = "chunk_causal_sgu_hgrn2_hybrid"


def layer_norm(x, g, b):
    xf = x.astype(jnp.float32)
    mu = jnp.mean(xf, axis=-1, keepdims=True)
    var = jnp.mean(jnp.square(xf - mu), axis=-1, keepdims=True)
    return ((xf - mu) * lax.rsqrt(var + LN_EPS)).astype(x.dtype) * g + b


def sgu_mixer(u, v, w_s, b_s, g_v, b_v):
    bsz, t_len, _ = u.shape
    n_blk = t_len // SGU_BLOCK
    v = layer_norm(v, g_v, b_v).reshape(bsz, n_blk, SGU_BLOCK, SGU_GROUPS, SGU_GROUP_DIM)
    chunk_id = jnp.arange(SGU_BLOCK) // CHUNK
    mask = chunk_id[:, None] >= chunk_id[None, :]
    w = jnp.where(mask[None], w_s, jnp.zeros((), w_s.dtype))
    mixed = jnp.einsum('gts,bnsgc->bntgc', w, v) + b_s.T[None, None, :, :, None]
    return u * mixed.reshape(bsz, t_len, SGU_WIDTH)


def hgrn2_mixer(q, f_pre, i_in, og, lb, g_norm):
    bsz, t_len, _ = q.shape
    n_chunk = t_len // CHUNK
    f32 = jnp.float32
    qf = jax.nn.silu(q.astype(f32))
    f = lb + (1.0 - lb) * jax.nn.sigmoid(f_pre.astype(f32))
    kf = 1.0 - f
    logf = jnp.log(f)

    def to_chunks(z):
        return z.reshape(bsz, n_chunk, CHUNK, HGRN_HEADS, HGRN_EXPAND).transpose(1, 0, 3, 2, 4)

    qc, kc, ic = to_chunks(qf), to_chunks(kf), to_chunks(i_in.astype(f32))
    cc = jnp.cumsum(to_chunks(logf), axis=3)
    tri = jnp.tril(jnp.ones((CHUNK, CHUNK), dtype=bool))

    def step(state, inp):
        qk, kk, ik, ck = inp
        diff = ck[:, :, :, None, :] - ck[:, :, None, :, :]
        decay = jnp.exp(jnp.where(tri[None, None, :, :, None], diff, -jnp.inf))
        attn = jnp.einsum('bhte,bhse,bhtse->bhts', qk, kk, decay)
        o = (jnp.einsum('bhts,bhsv->bhtv', attn, ik)
             + jnp.einsum('bhte,bhev->bhtv', qk * jnp.exp(ck), state))
        c_last = ck[:, :, -1:, :]
        state = (jnp.exp(c_last[:, :, 0, :])[..., None] * state
                 + jnp.einsum('bhse,bhsv->bhev', kk * jnp.exp(c_last - ck), ik))
        return state, o

    s0 = jnp.zeros((bsz, HGRN_HEADS, HGRN_EXPAND, HGRN_EXPAND), f32)
    _, o = lax.scan(step, s0, (qc, kc, ic, cc))
    o = o.transpose(1, 0, 3, 2, 4).reshape(bsz, t_len, HGRN_HEADS, HGRN_EXPAND)
    o = o * lax.rsqrt(jnp.mean(jnp.square(o), axis=-1, keepdims=True) + RMS_EPS)
    o = o.reshape(bsz, t_len, HGRN_WIDTH).astype(q.dtype) * g_norm
    return o * jax.nn.silu(og)


def causal_dwconv(x, w, b):
    y = lax.conv_general_dilated(
        x, w[:, None, :], window_strides=(1,), padding=[(CONV_WIDTH - 1, 0)],
        dimension_numbers=('NWC', 'WIO', 'NWC'), feature_group_count=x.shape[-1])
    return y + b


def conv_ffn(x, w_up, conv_w, conv_b, w_down):
    h = x @ w_up
    gate, val = h[..., :D_FF], h[..., D_FF:]
    gate = causal_dwconv(gate, conv_w, conv_b)
    return (jax.nn.gelu(gate) * val) @ w_down


def setup_inputs(seed: int = 0) -> dict:
    key = jax.random.key(seed)
    ks = jax.random.split(key, 24)
    n = lambda k, s, sc: jax.random.normal(k, s, jnp.float32) * sc
    L, D = DEPTH, D_MODEL
    return {
        "x": n(ks[0], (BATCH, SEQ, D), 1.0),
        "p": n(ks[1], (L, BATCH, SEQ, PLE_DIM), 1.0),
        "w_in": n(ks[2], (L, D, IN_COLS), D ** -0.5),
        "sgu_w_s": n(ks[3], (L, SGU_GROUPS, SGU_BLOCK, SGU_BLOCK), SGU_BLOCK ** -0.5),
        "sgu_b_s": 1.0 + n(ks[4], (L, SGU_GROUPS, SGU_BLOCK), 0.02),
        "sgu_norm_g": 1.0 + n(ks[5], (L, SGU_WIDTH), 0.02),
        "sgu_norm_b": n(ks[6], (L, SGU_WIDTH), 0.02),
        "hgrn_lb_logits": n(ks[7], (L + 1, HGRN_WIDTH), 0.1),
        "hgrn_norm_g": 1.0 + n(ks[8], (L, HGRN_WIDTH), 0.02),
        "w_branch": n(ks[9], (L, N_BRANCH, SGU_WIDTH, D), SGU_WIDTH ** -0.5),
        "w_out": n(ks[10], (L, D, D), D ** -0.5 * BETA),
        "ln1_g": 1.0 + n(ks[11], (L, D), 0.02),
        "ln1_b": n(ks[12], (L, D), 0.02),
        "ffn_w_up": n(ks[13], (L, D, 2 * D_FF), D ** -0.5),
        "ffn_conv_w": n(ks[14], (L, CONV_WIDTH, D_FF), CONV_WIDTH ** -0.5),
        "ffn_conv_b": n(ks[15], (L, D_FF), 0.02),
        "ffn_w_down": n(ks[16], (L, D_FF, D), D_FF ** -0.5 * BETA),
        "ln2_g": 1.0 + n(ks[17], (L, D), 0.02),
        "ln2_b": n(ks[18], (L, D), 0.02),
        "ple_w_proj": n(ks[19], (L, PLE_DIM, D), PLE_DIM ** -0.5 * BETA),
        "ple_w_gate": n(ks[20], (L, D, D), D ** -0.5),
    }


def reference(x, p, w_in, sgu_w_s, sgu_b_s, sgu_norm_g, sgu_norm_b, hgrn_lb_logits,
              hgrn_norm_g, w_branch, w_out, ln1_g, ln1_b, ffn_w_up, ffn_conv_w,
              ffn_conv_b, ffn_w_down, ln2_g, ln2_b, ple_w_proj, ple_w_gate):
    splits = [SGU_WIDTH, 2 * SGU_WIDTH,
              2 * SGU_WIDTH + HGRN_WIDTH, 2 * SGU_WIDTH + 2 * HGRN_WIDTH,
              2 * SGU_WIDTH + 3 * HGRN_WIDTH, 2 * SGU_WIDTH + 4 * HGRN_WIDTH,
              2 * SGU_WIDTH + 4 * HGRN_WIDTH + D_MODEL]
    lb_all = jnp.cumsum(jax.nn.softmax(hgrn_lb_logits.astype(jnp.float32), axis=0), axis=0)
    for l in range(DEPTH):
        h = x @ w_in[l]
        u, v, q, f_pre, i_in, og, g_a, g_b = jnp.split(h, splits, axis=-1)
        y_a = sgu_mixer(jax.nn.gelu(u), jax.nn.gelu(v), sgu_w_s[l], sgu_b_s[l],
                        sgu_norm_g[l], sgu_norm_b[l])
        y_b = hgrn2_mixer(q, f_pre, i_in, og, lb_all[l], hgrn_norm_g[l])
        merged = (jax.nn.sigmoid(g_a) * (y_a @ w_branch[l, 0])
                  + jax.nn.sigmoid(g_b) * (y_b @ w_branch[l, 1]))
        x = layer_norm(ALPHA * x + merged @ w_out[l], ln1_g[l], ln1_b[l])
        ffn = conv_ffn(x, ffn_w_up[l], ffn_conv_w[l], ffn_conv_b[l], ffn_w_down[l])
        ple = jax.nn.sigmoid(x @ ple_w_gate[l]) * (p[l] @ ple_w_proj[l])
        x = layer_norm(ALPHA * x + ffn + ple, ln2_g[l], ln2_b[l])
    return x
```

```cpp
#include <hip/hip_runtime.h>
#include <hip/hip_cooperative_groups.h>
#include <cstdio>
#include <cstdint>
namespace cg = cooperative_groups;

#define LAS __attribute__((address_space(3)))
typedef unsigned short bf16_t;
typedef short bf16x8 __attribute__((ext_vector_type(8)));
typedef float f32x4 __attribute__((ext_vector_type(4)));
typedef float f32x2 __attribute__((ext_vector_type(2)));
typedef unsigned u32x4 __attribute__((ext_vector_type(4)));
typedef unsigned u32x2 __attribute__((ext_vector_type(2)));

constexpr int M = 32768, D = 1024, SEQ = 4096, DFF = 2816, PLE = 256;
constexpr float LN_EPS = 1e-5f, RMS_EPS = 1e-6f;
constexpr float ALPHA = 1.189207115002721f;
constexpr int LDS_BYTES = 147456;

constexpr size_t MiB = 1u << 20;
constexpr size_t WS_LB = MiB / 2;
constexpr size_t WS_WIN = 1 * MiB, WS_WA = 17 * MiB, WS_WB = 19 * MiB, WS_WOUT = 21 * MiB, WS_WUP = 23 * MiB, WS_WDN = 34 * MiB, WS_WPG = 40 * MiB, WS_WPP = 42 * MiB;
constexpr size_t WS_DTAB = 43 * MiB;
constexpr size_t WS_XBF = 48 * MiB;
constexpr size_t WS_Q = 112 * MiB;
constexpr size_t WS_LOGF = 176 * MiB;
constexpr size_t WS_I = 240 * MiB;
constexpr size_t WS_OG = 304 * MiB;
constexpr size_t WS_U = 368 * MiB;
constexpr size_t WS_HH = 112 * MiB;
constexpr size_t WS_PBF = 496 * MiB;
constexpr size_t WS_NEED = 512 * MiB;

typedef __bf16 bf16x2_t __attribute__((ext_vector_type(2)));
__device__ __forceinline__ unsigned cvt_pk_bf16(float lo, float hi) { const f32x2 v = {lo, hi}; const bf16x2_t b = __builtin_convertvector(v, bf16x2_t); return __builtin_bit_cast(unsigned, b); }
__device__ __forceinline__ float bf_lo(unsigned w) { return __uint_as_float(w << 16); }
__device__ __forceinline__ float bf_hi(unsigned w) { return __uint_as_float(w & 0xffff0000u); }
__device__ __forceinline__ float bf2f(bf16_t h) { return __uint_as_float((unsigned)h << 16); }
__device__ __forceinline__ unsigned pk_f16(float lo, float hi) { const _Float16 a = (_Float16)lo, b = (_Float16)hi; return (unsigned)__builtin_bit_cast(unsigned short, a) | ((unsigned)__builtin_bit_cast(unsigned short, b) << 16); }
__device__ __forceinline__ float h_lo(unsigned w) { return (float)__builtin_bit_cast(_Float16, (unsigned short)(w & 0xffffu)); }
__device__ __forceinline__ float h_hi(unsigned w) { return (float)__builtin_bit_cast(_Float16, (unsigned short)(w >> 16)); }
__device__ __forceinline__ float sigmoidf_(float x) { return __builtin_amdgcn_rcpf(1.0f + __expf(-x)); }
__device__ __forceinline__ float siluf_(float x) { return x * sigmoidf_(x); }
__device__ __forceinline__ float geluf_(float x) { return x * sigmoidf_(1.5957691216057308f * (x + 0.044715f * x * x * x)); }
__device__ __forceinline__ int lane_id() { int l = (int)__builtin_amdgcn_mbcnt_hi(~0u, __builtin_amdgcn_mbcnt_lo(~0u, 0u)); asm volatile("" : "+v"(l)); return l; }
__device__ __forceinline__ float shfl_xor_l(float v, int o, int l) { return __int_as_float(__builtin_amdgcn_ds_bpermute((l ^ o) << 2, __float_as_int(v))); }
__device__ __forceinline__ float wave_sum(float v) {
    const int l = lane_id();
#pragma unroll
    for (int o = 1; o < 64; o <<= 1) v += shfl_xor_l(v, o, l);
    return v;
}

namespace pg8 {
constexpr int BM = 256, BK = 64, HALF = 128, HTB = HALF * BK * 2, STAGE_BYTES = 8 * HTB, NXCD = 8, WGM = 8;
__host__ __device__ __forceinline__ int lds_byte(int r, int c) { const int st = (r >> 4) * 2 + (c >> 5), rr = r & 15, cc = c & 31, ob = rr * 64 + cc * 2; return st * 1024 + (ob ^ (((ob >> 9) & 1) << 5)); }
__host__ __device__ __forceinline__ void stage_rc(int b, int& R, int& C) { const int st = b / 1024, sb = b % 1024, swz = sb ^ (((sb >> 9) & 1) << 5); R = (st >> 1) * 16 + swz / 64; C = (st & 1) * 32 + (swz % 64) / 2; }
__host__ __device__ __forceinline__ int perm32(int rho) { const int n = rho >> 4, i = rho & 15; return 8 * (i >> 2) + 4 * n + (i & 3); }

struct Unit { int pm, pn; };
struct Gemm { const bf16_t* A; const bf16_t* Bt; int M, N, K, lda; };

struct StaticOrder {
    int nM, nN, nwg, G, c;
    __device__ void init(int M_, int N_, int G_, int c_) { nM = M_ / BM; nN = N_ / BM; nwg = nM * nN; G = G_; c = c_; }
    __device__ bool next(int i, Unit& u) const {
        const long L = (long)i * G + c; if (L >= nwg) return false;
        int wgid = (int)L; { const int q = nwg / NXCD, r = nwg % NXCD, xcd = wgid % NXCD, off = wgid / NXCD; wgid = (xcd < r ? xcd * (q + 1) : r * (q + 1) + (xcd - r) * q) + off; }
        const int nig = WGM * nN, gid = wgid / nig, fm = gid * WGM, gsz = (nM - fm) < WGM ? (nM - fm) : WGM;
        u.pm = fm + ((wgid % nig) % gsz); u.pn = (wgid % nig) / gsz; return true;
    }
};

template <class Epi>
__device__ __forceinline__ void gemm_phase(LAS unsigned char* lds, const Gemm g, const StaticOrder& S, const Epi& E, const int wv) {
    int tid_ = wv * 64 + lane_id(); asm volatile("" : "+v"(tid_));
    const int tid = tid_, wid = __builtin_amdgcn_readfirstlane(tid >> 6), lane = tid & 63, wr = wid >> 2, wc = wid & 3, fr = lane & 15, fq = lane >> 4;
    const int K = g.K, nt = K / BK, lda = g.lda;
    unsigned voffA[2], voffB[2];
#pragma unroll
    for (int i = 0; i < 2; ++i) { int R, C; stage_rc(tid * 16 + i * 8192, R, C); const int Rb = Epi::PERM ? ((R & ~31) + perm32(R & 31)) : R;
        voffA[i] = (unsigned)(R * lda + C) * 2u; voffB[i] = (unsigned)(Rb * K + C) * 2u; }
    const size_t kstep = (size_t)(BK * 2);
    const size_t hstepA = (size_t)HALF * lda * 2, hstepB = (size_t)HALF * K * 2;
    const size_t tstepA = 2 * hstepA, tstepB = 2 * hstepB;
    const unsigned ldsw = (unsigned)wid * 1024u;
    const int aoff = lds_byte(wr * 64 + fr, fq * 8), boff = lds_byte(wc * 32 + fr, fq * 8);
#define PG8_SA(b, h) (((b) * 2 + (h)) * HTB)
#define PG8_SB(b, h) ((4 + (b) * 2 + (h)) * HTB)
#define PG8_STAGE(bufoff, gbase, voff) do { _Pragma("unroll") for (int _i = 0; _i < 2; ++_i) \
        __builtin_amdgcn_global_load_lds((const unsigned*)((const char*)(gbase) + (voff)[_i]), (LAS unsigned*)(lds + (bufoff) + ldsw + _i * 8192), 16, 0, 0); } while (0)
#define PG8_LDA(dst, b, h) do { _Pragma("unroll") for (int m = 0; m < 4; ++m) _Pragma("unroll") for (int k = 0; k < 2; ++k) dst[m][k] = *(const LAS bf16x8*)(lds + PG8_SA(b, h) + aoff + m * 2048 + k * 1024); } while (0)
#define PG8_LDB(dst, b, h) do { _Pragma("unroll") for (int n = 0; n < 2; ++n) _Pragma("unroll") for (int k = 0; k < 2; ++k) dst[n][k] = *(const LAS bf16x8*)(lds + PG8_SB(b, h) + boff + n * 2048 + k * 1024); } while (0)
#define PG8_MMA(ai, bj, At, Bt) do { __builtin_amdgcn_s_setprio(1); _Pragma("unroll") for (int m = 0; m < 4; ++m) _Pragma("unroll") for (int n = 0; n < 2; ++n) _Pragma("unroll") for (int k = 0; k < 2; ++k) \
        acc[ai][bj][m][n] = __builtin_amdgcn_mfma_f32_16x16x32_bf16(Bt[n][k], At[m][k], acc[ai][bj][m][n], 0, 0, 0); __builtin_amdgcn_s_setprio(0); } while (0)
#define PG8_WAIT_V(n) asm volatile("s_waitcnt vmcnt(" #n ")" ::: "memory")
#define PG8_WAIT_L(n) asm volatile("s_waitcnt lgkmcnt(" #n ")" ::: "memory")
#define PG8_BAR __builtin_amdgcn_s_barrier()
#define PG8_SCHED __builtin_amdgcn_sched_barrier(0)
    Unit cur, nxt; int ui = 0;
    if (!S.next(0, cur)) return;
    f32x4 acc[2][2][4][2];
#pragma unroll
    for (int a = 0; a < 2; ++a)
#pragma unroll
        for (int b = 0; b < 2; ++b)
#pragma unroll
            for (int m = 0; m < 4; ++m)
#pragma unroll
                for (int n = 0; n < 2; ++n) acc[a][b][m][n] = (f32x4){0.f, 0.f, 0.f, 0.f};
    bf16x8 At[4][2], B0[2][2], B1[2][2];
    const char* cA = (const char*)g.A + (size_t)cur.pm * tstepA; const char* cB = (const char*)g.Bt + (size_t)cur.pn * tstepB;
    PG8_STAGE(PG8_SB(0, 0), cB, voffB); PG8_STAGE(PG8_SB(0, 1), cB + hstepB, voffB); PG8_STAGE(PG8_SA(0, 0), cA, voffA); PG8_STAGE(PG8_SA(0, 1), cA + hstepA, voffA);
    if (wr == 1) PG8_BAR;
    PG8_WAIT_V(2); PG8_BAR;
    PG8_STAGE(PG8_SB(1, 0), cB + kstep, voffB); PG8_STAGE(PG8_SA(1, 0), cA + kstep, voffA); PG8_STAGE(PG8_SB(1, 1), cB + hstepB + kstep, voffB);
    PG8_WAIT_V(6); PG8_BAR;
    for (;;) {
        const bool has_next = S.next(ui + 1, nxt);
        const char* nA = has_next ? (const char*)g.A + (size_t)nxt.pm * tstepA : cA; const char* nB = has_next ? (const char*)g.Bt + (size_t)nxt.pn * tstepB : cB;
        for (int t = 0; t < nt; t += 2) {
            const bool last = (t == nt - 2);
            const char* a1 = cA + (size_t)(t + 1) * kstep;
            const char* a2 = last ? nA : cA + (size_t)(t + 2) * kstep; const char* b2 = last ? nB : cB + (size_t)(t + 2) * kstep;
            const char* a3 = a2 + kstep; const char* b3 = b2 + kstep;
            PG8_LDB(B0, 0, 0); PG8_LDB(B1, 0, 1); PG8_SCHED; PG8_LDA(At, 0, 0); PG8_STAGE(PG8_SA(1, 1), a1 + hstepA, voffA);
            PG8_WAIT_V(8); PG8_WAIT_L(0); PG8_BAR; PG8_MMA(0, 0, At, B0); PG8_MMA(0, 1, At, B1); PG8_BAR; PG8_SCHED;
            PG8_LDA(At, 0, 1); PG8_STAGE(PG8_SB(0, 0), b2, voffB); PG8_STAGE(PG8_SB(0, 1), b2 + hstepB, voffB); PG8_STAGE(PG8_SA(0, 0), a2, voffA);
            PG8_WAIT_V(8); PG8_WAIT_L(0); PG8_BAR; PG8_MMA(1, 0, At, B0); PG8_MMA(1, 1, At, B1); PG8_BAR; PG8_SCHED;
            PG8_LDB(B0, 1, 0); PG8_LDB(B1, 1, 1); PG8_SCHED; PG8_LDA(At, 1, 0); PG8_STAGE(PG8_SA(0, 1), a2 + hstepA, voffA);
            PG8_WAIT_V(8); PG8_WAIT_L(0); PG8_BAR; PG8_MMA(0, 0, At, B0); PG8_MMA(0, 1, At, B1); PG8_BAR; PG8_SCHED;
            PG8_LDA(At, 1, 1); PG8_STAGE(PG8_SB(1, 0), b3, voffB); PG8_STAGE(PG8_SB(1, 1), b3 + hstepB, voffB); PG8_STAGE(PG8_SA(1, 0), a3, voffA);
            PG8_WAIT_V(8); PG8_WAIT_L(0); PG8_BAR; PG8_MMA(1, 0, At, B0); PG8_MMA(1, 1, At, B1); PG8_BAR; PG8_SCHED;
        }
        if (wr == 0) PG8_BAR;
        E(acc, cur, wr, wc, fr, fq);
        if (!has_next) break;
#pragma unroll
        for (int a = 0; a < 2; ++a)
#pragma unroll
            for (int b = 0; b < 2; ++b)
#pragma unroll
                for (int m = 0; m < 4; ++m)
#pragma unroll
                    for (int n = 0; n < 2; ++n) acc[a][b][m][n] = (f32x4){0.f, 0.f, 0.f, 0.f};
        cur = nxt; cA = nA; cB = nB; ++ui;
        if (wr == 1) PG8_BAR;
    }
    PG8_WAIT_V(0);
    PG8_BAR;
#undef PG8_SA
#undef PG8_SB
#undef PG8_STAGE
#undef PG8_LDA
#undef PG8_LDB
#undef PG8_MMA
#undef PG8_WAIT_V
#undef PG8_WAIT_L
#undef PG8_BAR
#undef PG8_SCHED
}

enum { ACT_NONE = 0, ACT_GELU = 1, ACT_SILU = 2, ACT_SIGM = 3, ACT_LOGF = 4 };
template <int ACT> __device__ __forceinline__ float act_apply(float v, float lb) {
    if (ACT == ACT_GELU) return geluf_(v);
    if (ACT == ACT_SILU) return siluf_(v);
    if (ACT == ACT_SIGM) return sigmoidf_(v);
    if (ACT == ACT_LOGF) return __logf(lb + (1.0f - lb) * sigmoidf_(v));
    return v;
}
template <int ACT> __device__ __forceinline__ void epi16_store(const f32x4 (&acc)[2][2][4][2], bf16_t* base, int ldc, int row0, int col0, const float* lbp) {
    float lbv[2][8];
#pragma unroll
    for (int bj = 0; bj < 2; ++bj)
#pragma unroll
        for (int j = 0; j < 8; ++j) lbv[bj][j] = (ACT == ACT_LOGF) ? lbp[col0 + bj * HALF + j] : 0.f;
#pragma unroll
    for (int ai = 0; ai < 2; ++ai)
#pragma unroll
        for (int m = 0; m < 4; ++m) { bf16_t* rowp = base + (size_t)(row0 + ai * HALF + m * 16) * ldc + col0;
#pragma unroll
            for (int bj = 0; bj < 2; ++bj) { f32x4 v0 = acc[ai][bj][m][0], v1 = acc[ai][bj][m][1];
                asm volatile("; act %c2" : "+v"(v0), "+v"(v1) : "i"(ACT));
                float o[8];
#pragma unroll
                for (int j = 0; j < 4; ++j) { o[j] = act_apply<ACT>(v0[j], lbv[bj][j]); o[4 + j] = act_apply<ACT>(v1[j], lbv[bj][4 + j]); }
                u32x4 w;
                if (ACT == ACT_LOGF) { w.x = pk_f16(o[0], o[1]); w.y = pk_f16(o[2], o[3]); w.z = pk_f16(o[4], o[5]); w.w = pk_f16(o[6], o[7]); }
                else { w.x = cvt_pk_bf16(o[0], o[1]); w.y = cvt_pk_bf16(o[2], o[3]); w.z = cvt_pk_bf16(o[4], o[5]); w.w = cvt_pk_bf16(o[6], o[7]); }
                *(u32x4*)(rowp + bj * HALF) = w; } }
}
struct EpiSec {
    static constexpr bool PERM = true;
    bf16_t* d0; size_t sec_stride; int acts; int ldc, sec_cols; const float* lb;
    __device__ __forceinline__ void operator()(const f32x4 (&acc)[2][2][4][2], const Unit& u, int wr, int wc, int fr, int fq) const {
        { int t_ = lane_id(); asm volatile("" : "+v"(t_)); fr = t_ & 15; fq = (t_ >> 4) & 3; }
        const int colt = u.pn * BM, sec = colt / sec_cols, colin = colt - sec * sec_cols;
        bf16_t* base = d0 + (size_t)sec * sec_stride;
        const int a = (acts >> (4 * sec)) & 15;
        const int row0 = u.pm * BM + wr * 64 + fr, col0 = colin + wc * 32 + 8 * fq;
        if (a == ACT_NONE) epi16_store<ACT_NONE>(acc, base, ldc, row0, col0, lb);
        else if (a == ACT_GELU) epi16_store<ACT_GELU>(acc, base, ldc, row0, col0, lb);
        else if (a == ACT_SILU) epi16_store<ACT_SILU>(acc, base, ldc, row0, col0, lb);
        else if (a == ACT_SIGM) epi16_store<ACT_SIGM>(acc, base, ldc, row0, col0, lb);
        else epi16_store<ACT_LOGF>(acc, base, ldc, row0, col0, lb);
    }
};
enum { MODE_T = 0, MODE_M = 1, MODE_Z = 2, MODE_E = 3, MODE_PLE = 4, MODE_FIN = 5 };
__device__ __forceinline__ f32x4 ld_bf4(const bf16_t* p) { const u32x2 w = *(const u32x2*)p; return (f32x4){bf_lo(w.x), bf_hi(w.x), bf_lo(w.y), bf_hi(w.y)}; }
__device__ __forceinline__ void st_bf4(bf16_t* p, const f32x4 o) { u32x2 w; w.x = cvt_pk_bf16(o[0], o[1]); w.y = cvt_pk_bf16(o[2], o[3]); *(u32x2*)p = w; }
template <int MODE> struct EpiF32 {
    static constexpr bool PERM = false;
    float* out; const float* in; const bf16_t* g; const bf16_t* ib; int ldib; bf16_t* ob; int ldob;
    __device__ __forceinline__ void operator()(const f32x4 (&acc)[2][2][4][2], const Unit& u, int wr, int wc, int fr, int fq) const {
        { int t_ = lane_id(); asm volatile("" : "+v"(t_)); fr = t_ & 15; fq = (t_ >> 4) & 3; }
        const int row0 = u.pm * BM + wr * 64 + fr, col0 = u.pn * BM + wc * 32 + 4 * fq;
#pragma unroll
        for (int ai = 0; ai < 2; ++ai)
#pragma unroll
            for (int m = 0; m < 4; ++m) { const size_t r = (size_t)(row0 + ai * HALF + m * 16);
#pragma unroll
                for (int bj = 0; bj < 2; ++bj)
#pragma unroll
                    for (int n = 0; n < 2; ++n) { const int c = col0 + bj * HALF + n * 16; const f32x4 v = acc[ai][bj][m][n];
                        if (MODE == MODE_T) { st_bf4(ob + r * ldob + c, v * ld_bf4(g + r * 1024 + c)); }
                        else if (MODE == MODE_M) { st_bf4(ob + r * ldob + c, ld_bf4(ib + r * ldib + c) + v * ld_bf4(g + r * 1024 + c)); }
                        else if (MODE == MODE_Z) { const f32x4 xx = *(const f32x4*)(in + r * 1024 + c); st_bf4(ob + r * ldob + c, xx * ALPHA + v); }
                        else if (MODE == MODE_E) { st_bf4(ob + r * ldob + c, v); }
                        else if (MODE == MODE_PLE) { const f32x4 e = ld_bf4(ib + r * ldib + c); st_bf4(ob + r * ldob + c, (f32x4){sigmoidf_(v[0]) * e[0], sigmoidf_(v[1]) * e[1], sigmoidf_(v[2]) * e[2], sigmoidf_(v[3]) * e[3]}); }
                        else { const f32x4 x1 = ld_bf4(g + r * 1024 + c), pl = ld_bf4(ib + r * ldib + c); st_bf4(ob + r * ldob + c, x1 * ALPHA + pl + v); }
                    }
                asm volatile("" ::: "memory"); }
    }
};
}

__device__ __forceinline__ void p0_transpose_item(const float* W, int K, int N, bf16_t* WT, int row_off, LAS float* scr, int item, int lane) {
    const int nblk = N / 32, kb = item / nblk, nb = item % nblk, k0 = 64 * kb, n0 = 32 * nb;
#pragma unroll 8
    for (int i = 0; i < 32; ++i) { const int kk = 2 * i + (lane >> 5); scr[kk * 33 + (lane & 31)] = W[(size_t)(k0 + kk) * N + n0 + (lane & 31)]; }
    asm volatile("s_waitcnt lgkmcnt(0)" ::: "memory");
    const int c = lane & 7;
#pragma unroll
    for (int j = 0; j < 4; ++j) { const int n = (lane >> 3) + 8 * j; const LAS float* s = scr + (8 * c) * 33 + n;
        u32x4 o; o.x = cvt_pk_bf16(s[0 * 33], s[1 * 33]); o.y = cvt_pk_bf16(s[2 * 33], s[3 * 33]); o.z = cvt_pk_bf16(s[4 * 33], s[5 * 33]); o.w = cvt_pk_bf16(s[6 * 33], s[7 * 33]);
        *(u32x4*)(WT + (size_t)(row_off + n0 + n) * K + k0 + 8 * c) = o; }
    asm volatile("s_waitcnt lgkmcnt(0)" ::: "memory");
}
__device__ __forceinline__ void cvt_f32_bf16(const float* src, bf16_t* dst, size_t nvec, size_t gt, size_t nthreads) {
    size_t i = gt;
    for (; i + 3 * nthreads < nvec; i += 4 * nthreads) { f32x4 a[4], b[4];
#pragma unroll
        for (int u = 0; u < 4; ++u) { a[u] = *(const f32x4*)(src + (i + u * nthreads) * 8); b[u] = *(const f32x4*)(src + (i + u * nthreads) * 8 + 4); }
#pragma unroll
        for (int u = 0; u < 4; ++u) { u32x4 o; o.x = cvt_pk_bf16(a[u][0], a[u][1]); o.y = cvt_pk_bf16(a[u][2], a[u][3]); o.z = cvt_pk_bf16(b[u][0], b[u][1]); o.w = cvt_pk_bf16(b[u][2], b[u][3]); *(u32x4*)(dst + (i + u * nthreads) * 8) = o; } }
    for (; i < nvec; i += nthreads) { const f32x4 a = *(const f32x4*)(src + i * 8), b = *(const f32x4*)(src + i * 8 + 4);
        u32x4 o; o.x = cvt_pk_bf16(a[0], a[1]); o.y = cvt_pk_bf16(a[2], a[3]); o.z = cvt_pk_bf16(b[0], b[1]); o.w = cvt_pk_bf16(b[2], b[3]); *(u32x4*)(dst + i * 8) = o; }
}

__device__ __forceinline__ bf16x8 ldfrag(const LAS bf16_t* base, int row, int ld, int k) { return *(const LAS bf16x8*)(base + row * ld + k); }

__device__ __forceinline__ void hgrn_pass_b2(LAS unsigned char* lds, const _Float16* LOGF, const bf16_t* I, bf16_t* U, float* Dtab, int itemA, int itemB, const int wv) {
    int tid_ = wv * 64 + lane_id(); asm volatile("" : "+v"(tid_)); const int tid = tid_, lane = tid & 63, w = tid >> 6;
    const int e = tid & 127, part = tid >> 7;
    float lf[2][16], cum[2][16]; unsigned short iv[2][16]; float sum[2];
#pragma unroll
    for (int u = 0; u < 2; ++u) { const int item = u ? itemB : itemA; const int c = item & 63, bh = item >> 6, h = bh & 7, b = bh >> 3; const size_t r0 = (size_t)b * SEQ + (size_t)c * 64;
#pragma unroll
        for (int j = 0; j < 16; ++j) { const size_t off = (r0 + 16 * part + j) * 1024 + h * 128 + e; lf[u][j] = (float)LOGF[off]; iv[u][j] = I[off]; } }
#pragma unroll
    for (int u = 0; u < 2; ++u) { LAS bf16_t* kT = (LAS bf16_t*)(lds + u * 38912); LAS bf16_t* iT = kT + 128 * 72; LAS float* tot = (LAS float*)(iT + 128 * 72);
        float s = 0.f;
#pragma unroll
        for (int j = 0; j < 16; ++j) { s += lf[u][j]; cum[u][j] = s; }
        sum[u] = s; tot[part * 128 + e] = s;
        u32x4 w0, w1;
        w0.x = iv[u][0] | ((unsigned)iv[u][1] << 16); w0.y = iv[u][2] | ((unsigned)iv[u][3] << 16); w0.z = iv[u][4] | ((unsigned)iv[u][5] << 16); w0.w = iv[u][6] | ((unsigned)iv[u][7] << 16);
        w1.x = iv[u][8] | ((unsigned)iv[u][9] << 16); w1.y = iv[u][10] | ((unsigned)iv[u][11] << 16); w1.z = iv[u][12] | ((unsigned)iv[u][13] << 16); w1.w = iv[u][14] | ((unsigned)iv[u][15] << 16);
        *(LAS u32x4*)(iT + e * 72 + 16 * part) = w0; *(LAS u32x4*)(iT + e * 72 + 16 * part + 8) = w1; }
    __syncthreads();
#pragma unroll
    for (int u = 0; u < 2; ++u) { const int item = u ? itemB : itemA; LAS bf16_t* kT = (LAS bf16_t*)(lds + u * 38912); LAS bf16_t* iT = kT + 128 * 72; LAS float* tot = (LAS float*)(iT + 128 * 72);
        float off = 0.f, total = 0.f;
#pragma unroll
        for (int p = 0; p < 4; ++p) { const float t = tot[p * 128 + e]; if (p < part) off += t; total += t; }
        float kp[16];
#pragma unroll
        for (int j = 0; j < 16; ++j) kp[j] = (1.0f - __expf(lf[u][j])) * __expf(total - (off + cum[u][j]));
        u32x4 w0, w1;
        w0.x = cvt_pk_bf16(kp[0], kp[1]); w0.y = cvt_pk_bf16(kp[2], kp[3]); w0.z = cvt_pk_bf16(kp[4], kp[5]); w0.w = cvt_pk_bf16(kp[6], kp[7]);
        w1.x = cvt_pk_bf16(kp[8], kp[9]); w1.y = cvt_pk_bf16(kp[10], kp[11]); w1.z = cvt_pk_bf16(kp[12], kp[13]); w1.w = cvt_pk_bf16(kp[14], kp[15]);
        *(LAS u32x4*)(kT + e * 72 + 16 * part) = w0; *(LAS u32x4*)(kT + e * 72 + 16 * part + 8) = w1;
        if (part == 0) Dtab[(size_t)item * 128 + e] = __expf(total); }
    __syncthreads();
#pragma unroll
    for (int u = 0; u < 2; ++u) { const int item = u ? itemB : itemA; const LAS bf16_t* kT = (const LAS bf16_t*)(lds + u * 38912); const LAS bf16_t* iT = kT + 128 * 72;
        bf16x8 yf[2];
#pragma unroll
        for (int ks = 0; ks < 2; ++ks) yf[ks] = ldfrag(iT, 16 * w + (lane & 15), 72, ks * 32 + (lane >> 4) * 8);
        bf16_t* Ub = U + (size_t)item * 16384 + (size_t)(16 * w + (lane & 15)) * 128 + (lane >> 4) * 4;
#pragma unroll
        for (int te = 0; te < 8; ++te) { f32x4 acc = {0.f, 0.f, 0.f, 0.f};
#pragma unroll
            for (int ks = 0; ks < 2; ++ks) { const bf16x8 xf = ldfrag(kT, 16 * te + (lane & 15), 72, ks * 32 + (lane >> 4) * 8); acc = __builtin_amdgcn_mfma_f32_16x16x32_bf16(xf, yf[ks], acc, 0, 0, 0); }
            u32x2 o; o.x = cvt_pk_bf16(acc[0], acc[1]); o.y = cvt_pk_bf16(acc[2], acc[3]); *(u32x2*)(Ub + 16 * te) = o; } }
    __syncthreads();
}

__device__ __forceinline__ void hgrn_scan(bf16_t* U, const float* Dtab, int gt, int nthreads) {
    for (int idx = gt; idx < 64 * 2048; idx += nthreads) {
        const int bh = idx >> 11, el = (idx & 2047) * 8, e8 = el & 127;
        float S[8];
#pragma unroll
        for (int j = 0; j < 8; ++j) S[j] = 0.f;
#pragma unroll 8
        for (int c = 0; c < 64; ++c) { const size_t item = (size_t)bh * 64 + c;
            u32x4* up = (u32x4*)(U + item * 16384 + el); const u32x4 uv = *up;
            const f32x4 d0 = *(const f32x4*)(Dtab + item * 128 + e8), d1 = *(const f32x4*)(Dtab + item * 128 + e8 + 4);
            u32x4 o; o.x = cvt_pk_bf16(S[0], S[1]); o.y = cvt_pk_bf16(S[2], S[3]); o.z = cvt_pk_bf16(S[4], S[5]); o.w = cvt_pk_bf16(S[6], S[7]); *up = o;
            S[0] = d0[0] * S[0] + bf_lo(uv.x); S[1] = d0[1] * S[1] + bf_hi(uv.x); S[2] = d0[2] * S[2] + bf_lo(uv.y); S[3] = d0[3] * S[3] + bf_hi(uv.y);
            S[4] = d1[0] * S[4] + bf_lo(uv.z); S[5] = d1[1] * S[5] + bf_hi(uv.z); S[6] = d1[2] * S[6] + bf_lo(uv.w); S[7] = d1[3] * S[7] + bf_hi(uv.w); }
    }
}

__device__ __forceinline__ void hgrn_pass_ad(LAS unsigned char* lds, bf16_t* Q, const _Float16* LOGF, const bf16_t* I, const bf16_t* OG, const bf16_t* U, const float* gnorm, int item, const int wv) {
    int tid_ = wv * 64 + lane_id(); asm volatile("" : "+v"(tid_)); const int tid = tid_, lane = tid & 63, w = tid >> 6;
    const int c = item & 63, bh = item >> 6, h = bh & 7, b = bh >> 3;
    const size_t r0 = (size_t)b * SEQ + (size_t)c * 64;
    LAS bf16_t* qs = (LAS bf16_t*)lds;
    LAS bf16_t* ks_ = (LAS bf16_t*)(lds + 17408);
    LAS bf16_t* iT = (LAS bf16_t*)(lds + 34816);
    LAS bf16_t* ST = (LAS bf16_t*)(lds + 53248);
    LAS bf16_t* at = (LAS bf16_t*)(lds + 88064);
    LAS float* Cb = (LAS float*)(lds + 97280);
    LAS float* tot = (LAS float*)(lds + 131072);
    const int e = tid & 127, part = tid >> 7;
    u32x4 q8h[2], l8h[2];
#pragma unroll
    for (int rr = 0; rr < 2; ++rr) { const size_t off = (r0 + (tid >> 4) + 32 * rr) * 1024 + h * 128 + (tid & 15) * 8; q8h[rr] = *(const u32x4*)(Q + off); l8h[rr] = *(const u32x4*)((const bf16_t*)LOGF + off); }
    const size_t ogoff = (r0 + (tid >> 3)) * 1024 + h * 128 + (tid & 7) * 16;
    const u32x4 g0 = *(const u32x4*)(OG + ogoff), g1 = *(const u32x4*)(OG + ogoff + 8);
    float cum[16];
    { float s = 0.f; unsigned short iv[16];
#pragma unroll
      for (int j = 0; j < 16; ++j) { const size_t off = (r0 + 16 * part + j) * 1024 + h * 128 + e; s += (float)LOGF[off]; cum[j] = s; iv[j] = I[off]; }
      tot[part * 128 + e] = s;
      u32x4 w0, w1;
      w0.x = iv[0] | ((unsigned)iv[1] << 16); w0.y = iv[2] | ((unsigned)iv[3] << 16); w0.z = iv[4] | ((unsigned)iv[5] << 16); w0.w = iv[6] | ((unsigned)iv[7] << 16);
      w1.x = iv[8] | ((unsigned)iv[9] << 16); w1.y = iv[10] | ((unsigned)iv[11] << 16); w1.z = iv[12] | ((unsigned)iv[13] << 16); w1.w = iv[14] | ((unsigned)iv[15] << 16);
      *(LAS u32x4*)(iT + e * 72 + 16 * part) = w0; *(LAS u32x4*)(iT + e * 72 + 16 * part + 8) = w1; }
#pragma unroll
    for (int k = 0; k < 4; ++k) { const int idx = tid + 512 * k, v = idx >> 4, e8 = (idx & 15) * 8;
        *(LAS u32x4*)(ST + v * 136 + e8) = *(const u32x4*)(U + (size_t)item * 16384 + v * 128 + e8); }
    __syncthreads();
    { float off = 0.f;
#pragma unroll
      for (int p = 0; p < 3; ++p) { const float t = tot[p * 128 + e]; if (p < part) off += t; }
#pragma unroll
      for (int j = 0; j < 16; ++j) Cb[(16 * part + j) * 132 + e] = off + cum[j]; }
    __syncthreads();
#pragma unroll
    for (int rr = 0; rr < 2; ++rr) { const int t = (tid >> 4) + 32 * rr, e8 = (tid & 15) * 8;
        const u32x4 q8 = q8h[rr]; const u32x4 l8 = l8h[rr];
        const f32x4 c0 = *(const LAS f32x4*)(Cb + t * 132 + e8), c1 = *(const LAS f32x4*)(Cb + t * 132 + e8 + 4);
        float qv[8] = {bf_lo(q8.x), bf_hi(q8.x), bf_lo(q8.y), bf_hi(q8.y), bf_lo(q8.z), bf_hi(q8.z), bf_lo(q8.w), bf_hi(q8.w)};
        float lv[8] = {h_lo(l8.x), h_hi(l8.x), h_lo(l8.y), h_hi(l8.y), h_lo(l8.z), h_hi(l8.z), h_lo(l8.w), h_hi(l8.w)};
        float cv[8] = {c0[0], c0[1], c0[2], c0[3], c1[0], c1[1], c1[2], c1[3]};
        float qt[8], kt[8];
#pragma unroll
        for (int j = 0; j < 8; ++j) { qt[j] = qv[j] * __expf(cv[j]); kt[j] = (1.0f - __expf(lv[j])) * __expf(-cv[j]); }
        u32x4 wq, wk;
        wq.x = cvt_pk_bf16(qt[0], qt[1]); wq.y = cvt_pk_bf16(qt[2], qt[3]); wq.z = cvt_pk_bf16(qt[4], qt[5]); wq.w = cvt_pk_bf16(qt[6], qt[7]);
        wk.x = cvt_pk_bf16(kt[0], kt[1]); wk.y = cvt_pk_bf16(kt[2], kt[3]); wk.z = cvt_pk_bf16(kt[4], kt[5]); wk.w = cvt_pk_bf16(kt[6], kt[7]);
        *(LAS u32x4*)(qs + t * 136 + e8) = wq; *(LAS u32x4*)(ks_ + t * 136 + e8) = wk; }
    __syncthreads();
    { const int tt = w >> 1;
#pragma unroll
      for (int ts2 = 0; ts2 < 2; ++ts2) { const int ts = 2 * (w & 1) + ts2; f32x4 acc = {0.f, 0.f, 0.f, 0.f};
#pragma unroll
          for (int kk = 0; kk < 4; ++kk) { const bf16x8 xf = ldfrag(ks_, 16 * ts + (lane & 15), 136, kk * 32 + (lane >> 4) * 8), yf = ldfrag(qs, 16 * tt + (lane & 15), 136, kk * 32 + (lane >> 4) * 8);
              acc = __builtin_amdgcn_mfma_f32_16x16x32_bf16(xf, yf, acc, 0, 0, 0); }
          const int t = 16 * tt + (lane & 15), s0 = 16 * ts + (lane >> 4) * 4;
          float a0 = (s0 + 0 <= t) ? acc[0] : 0.f, a1 = (s0 + 1 <= t) ? acc[1] : 0.f, a2 = (s0 + 2 <= t) ? acc[2] : 0.f, a3 = (s0 + 3 <= t) ? acc[3] : 0.f;
          u32x2 o; o.x = cvt_pk_bf16(a0, a1); o.y = cvt_pk_bf16(a2, a3); *(LAS u32x2*)(at + t * 72 + s0) = o; } }
    __syncthreads();
    { bf16x8 xi[2], xs[4];
#pragma unroll
      for (int kk = 0; kk < 2; ++kk) xi[kk] = ldfrag(iT, 16 * w + (lane & 15), 72, kk * 32 + (lane >> 4) * 8);
#pragma unroll
      for (int kk = 0; kk < 4; ++kk) xs[kk] = ldfrag(ST, 16 * w + (lane & 15), 136, kk * 32 + (lane >> 4) * 8);
#pragma unroll
      for (int tt = 0; tt < 4; ++tt) { f32x4 acc = {0.f, 0.f, 0.f, 0.f};
#pragma unroll
          for (int kk = 0; kk < 2; ++kk) { const bf16x8 yf = ldfrag(at, 16 * tt + (lane & 15), 72, kk * 32 + (lane >> 4) * 8); acc = __builtin_amdgcn_mfma_f32_16x16x32_bf16(xi[kk], yf, acc, 0, 0, 0); }
#pragma unroll
          for (int kk = 0; kk < 4; ++kk) { const bf16x8 yf = ldfrag(qs, 16 * tt + (lane & 15), 136, kk * 32 + (lane >> 4) * 8); acc = __builtin_amdgcn_mfma_f32_16x16x32_bf16(xs[kk], yf, acc, 0, 0, 0); }
          *(LAS f32x4*)(Cb + (16 * tt + (lane & 15)) * 132 + 16 * w + (lane >> 4) * 4) = acc; } }
    __syncthreads();
    { const int t = tid >> 3, v16 = (tid & 7) * 16; float ov[16]; float ss = 0.f;
#pragma unroll
      for (int k = 0; k < 4; ++k) { const f32x4 x = *(const LAS f32x4*)(Cb + t * 132 + v16 + 4 * k); ov[4 * k] = x[0]; ov[4 * k + 1] = x[1]; ov[4 * k + 2] = x[2]; ov[4 * k + 3] = x[3]; ss += (x[0] * x[0] + x[1] * x[1]) + (x[2] * x[2] + x[3] * x[3]); }
      { const int l_ = lane_id(); ss += shfl_xor_l(ss, 1, l_); ss += shfl_xor_l(ss, 2, l_); ss += shfl_xor_l(ss, 4, l_); }
      const float rstd = rsqrtf(ss * (1.0f / 128.0f) + RMS_EPS);
      const size_t off = (r0 + t) * 1024 + h * 128 + v16;
      const float gg[16] = {bf_lo(g0.x), bf_hi(g0.x), bf_lo(g0.y), bf_hi(g0.y), bf_lo(g0.z), bf_hi(g0.z), bf_lo(g0.w), bf_hi(g0.w), bf_lo(g1.x), bf_hi(g1.x), bf_lo(g1.y), bf_hi(g1.y), bf_lo(g1.z), bf_hi(g1.z), bf_lo(g1.w), bf_hi(g1.w)};
      float y[16];
#pragma unroll
      for (int k = 0; k < 4; ++k) { const f32x4 gn = *(const f32x4*)(gnorm + h * 128 + v16 + 4 * k);
#pragma unroll
          for (int j = 0; j < 4; ++j) y[4 * k + j] = ov[4 * k + j] * rstd * gn[j] * gg[4 * k + j]; }
      u32x4 o0, o1;
      o0.x = cvt_pk_bf16(y[0], y[1]); o0.y = cvt_pk_bf16(y[2], y[3]); o0.z = cvt_pk_bf16(y[4], y[5]); o0.w = cvt_pk_bf16(y[6], y[7]);
      o1.x = cvt_pk_bf16(y[8], y[9]); o1.y = cvt_pk_bf16(y[10], y[11]); o1.z = cvt_pk_bf16(y[12], y[13]); o1.w = cvt_pk_bf16(y[14], y[15]);
      *(u32x4*)(Q + off) = o0; *(u32x4*)(Q + off + 8) = o1; }
    __syncthreads();
}

__device__ __forceinline__ void sgu_item(LAS unsigned char* lds, bf16_t* UU, const bf16_t* V, const float* w_s, const float* b_s, const float* gv, const float* bv, int nb, const int wv) {
    int tid_ = wv * 64 + lane_id(); asm volatile("" : "+v"(tid_)); const int tid = tid_, lane = tid & 63, w = tid >> 6;
    const size_t r0 = (size_t)nb * 128;
    LAS bf16_t* vnT = (LAS bf16_t*)lds;
    LAS bf16_t* Wl = (LAS bf16_t*)(lds + 34816);
    LAS float* stats = (LAS float*)(lds + 69632);
    for (int rr = 0; rr < 16; ++rr) { const int row = 16 * w + rr; const bf16_t* vp = V + (r0 + row) * 1024 + lane * 16;
        const u32x4 a = *(const u32x4*)vp, b = *(const u32x4*)(vp + 8);
        float x[16] = {bf_lo(a.x), bf_hi(a.x), bf_lo(a.y), bf_hi(a.y), bf_lo(a.z), bf_hi(a.z), bf_lo(a.w), bf_hi(a.w), bf_lo(b.x), bf_hi(b.x), bf_lo(b.y), bf_hi(b.y), bf_lo(b.z), bf_hi(b.z), bf_lo(b.w), bf_hi(b.w)};
        float s = 0.f;
#pragma unroll
        for (int j = 0; j < 16; ++j) s += x[j];
        const float mean = wave_sum(s) * (1.0f / 1024.0f); float q = 0.f;
#pragma unroll
        for (int j = 0; j < 16; ++j) { const float d = x[j] - mean; q += d * d; }
        const float rstd = rsqrtf(wave_sum(q) * (1.0f / 1024.0f) + LN_EPS);
        if (lane == 0) { stats[row * 2] = mean; stats[row * 2 + 1] = rstd; } }
    __syncthreads();
    for (int g = 0; g < 8; ++g) {
        { const int c = tid & 127, part = tid >> 7; const float gam = gv[g * 128 + c], bet = bv[g * 128 + c];
#pragma unroll
          for (int k = 0; k < 4; ++k) { float vn[8];
#pragma unroll
              for (int j = 0; j < 8; ++j) { const int s = 32 * part + 8 * k + j; const float x = bf2f(V[(r0 + s) * 1024 + g * 128 + c]); vn[j] = (x - stats[s * 2]) * stats[s * 2 + 1] * gam + bet; }
              u32x4 o; o.x = cvt_pk_bf16(vn[0], vn[1]); o.y = cvt_pk_bf16(vn[2], vn[3]); o.z = cvt_pk_bf16(vn[4], vn[5]); o.w = cvt_pk_bf16(vn[6], vn[7]);
              *(LAS u32x4*)(vnT + c * 136 + 32 * part + 8 * k) = o; } }
#pragma unroll
        for (int k = 0; k < 8; ++k) { const int idx = tid + 512 * k, t = idx >> 5, s4 = (idx & 31) * 4;
            f32x4 ww = *(const f32x4*)(w_s + (size_t)g * 16384 + t * 128 + s4);
            if (t < 64 && s4 >= 64) ww = (f32x4){0.f, 0.f, 0.f, 0.f};
            u32x2 o; o.x = cvt_pk_bf16(ww[0], ww[1]); o.y = cvt_pk_bf16(ww[2], ww[3]); *(LAS u32x2*)(Wl + t * 136 + s4) = o; }
        __syncthreads();
        bf16x8 xf[4];
#pragma unroll
        for (int kk = 0; kk < 4; ++kk) xf[kk] = ldfrag(vnT, 16 * w + (lane & 15), 136, kk * 32 + (lane >> 4) * 8);
#pragma unroll
        for (int tt = 0; tt < 8; ++tt) { f32x4 acc = {0.f, 0.f, 0.f, 0.f};
#pragma unroll
            for (int kk = 0; kk < 4; ++kk) { const bf16x8 yf = ldfrag(Wl, 16 * tt + (lane & 15), 136, kk * 32 + (lane >> 4) * 8); acc = __builtin_amdgcn_mfma_f32_16x16x32_bf16(xf[kk], yf, acc, 0, 0, 0); }
            const int t = 16 * tt + (lane & 15); const float bsv = b_s[g * 128 + t];
            bf16_t* up = UU + (r0 + t) * 1024 + g * 128 + 16 * w + (lane >> 4) * 4;
            const u32x2 uu = *(const u32x2*)up;
            u32x2 o; o.x = cvt_pk_bf16(bf_lo(uu.x) * (acc[0] + bsv), bf_hi(uu.x) * (acc[1] + bsv)); o.y = cvt_pk_bf16(bf_lo(uu.y) * (acc[2] + bsv), bf_hi(uu.y) * (acc[3] + bsv));
            *(u32x2*)up = o; }
        __syncthreads();
    }
}

template <int MODE> __device__ __forceinline__ void ln_row2(float* row0, float* row1, bf16_t* xb0, bf16_t* xb1, const float* g, const float* b, int lane) {
    f32x4* xr0 = (f32x4*)row0 + lane; f32x4* xr1 = (f32x4*)row1 + lane; f32x4 v0[4], v1[4]; float s0 = 0.f, s1 = 0.f;
#pragma unroll
    for (int j = 0; j < 4; ++j) { v0[j] = xr0[64 * j]; v1[j] = xr1[64 * j]; }
#pragma unroll
    for (int j = 0; j < 4; ++j) { s0 += (v0[j][0] + v0[j][1]) + (v0[j][2] + v0[j][3]); s1 += (v1[j][0] + v1[j][1]) + (v1[j][2] + v1[j][3]); }
    const float m0 = wave_sum(s0) * (1.f / 1024.f), m1 = wave_sum(s1) * (1.f / 1024.f); float q0 = 0.f, q1 = 0.f;
#pragma unroll
    for (int j = 0; j < 4; ++j) { v0[j] = v0[j] - m0; v1[j] = v1[j] - m1; q0 += (v0[j][0] * v0[j][0] + v0[j][1] * v0[j][1]) + (v0[j][2] * v0[j][2] + v0[j][3] * v0[j][3]); q1 += (v1[j][0] * v1[j][0] + v1[j][1] * v1[j][1]) + (v1[j][2] * v1[j][2] + v1[j][3] * v1[j][3]); }
    const float r0 = rsqrtf(wave_sum(q0) * (1.f / 1024.f) + LN_EPS), r1 = rsqrtf(wave_sum(q1) * (1.f / 1024.f) + LN_EPS);
#pragma unroll
    for (int j = 0; j < 4; ++j) { const f32x4 gg = *((const f32x4*)g + lane + 64 * j), bb = *((const f32x4*)b + lane + 64 * j); const f32x4 y0 = v0[j] * r0 * gg + bb, y1 = v1[j] * r1 * gg + bb;
        if (MODE == 0) { u32x2 o; o.x = cvt_pk_bf16(y0[0], y0[1]); o.y = cvt_pk_bf16(y0[2], y0[3]); *((u32x2*)xb0 + lane + 64 * j) = o; xr0[64 * j] = y0 * ALPHA;
                         u32x2 p; p.x = cvt_pk_bf16(y1[0], y1[1]); p.y = cvt_pk_bf16(y1[2], y1[3]); *((u32x2*)xb1 + lane + 64 * j) = p; xr1[64 * j] = y1 * ALPHA; }
        else { xr0[64 * j] = y0; xr1[64 * j] = y1; } }
}

__device__ __forceinline__ void ln1_rows_bf16(const bf16_t* z0, const bf16_t* z1, bf16_t* x0, bf16_t* x1, const float* g, const float* b, int lane) {
    float v[2][16];
#pragma unroll
    for (int u = 0; u < 2; ++u) { const bf16_t* zp = (u ? z1 : z0) + lane * 16; const u32x4 a = *(const u32x4*)zp, c = *(const u32x4*)(zp + 8);
        v[u][0] = bf_lo(a.x); v[u][1] = bf_hi(a.x); v[u][2] = bf_lo(a.y); v[u][3] = bf_hi(a.y); v[u][4] = bf_lo(a.z); v[u][5] = bf_hi(a.z); v[u][6] = bf_lo(a.w); v[u][7] = bf_hi(a.w);
        v[u][8] = bf_lo(c.x); v[u][9] = bf_hi(c.x); v[u][10] = bf_lo(c.y); v[u][11] = bf_hi(c.y); v[u][12] = bf_lo(c.z); v[u][13] = bf_hi(c.z); v[u][14] = bf_lo(c.w); v[u][15] = bf_hi(c.w); }
    float gg[16], bb[16];
#pragma unroll
    for (int k = 0; k < 4; ++k) { const f32x4 g4 = *(const f32x4*)(g + lane * 16 + 4 * k), b4 = *(const f32x4*)(b + lane * 16 + 4 * k);
#pragma unroll
        for (int j = 0; j < 4; ++j) { gg[4 * k + j] = g4[j]; bb[4 * k + j] = b4[j]; } }
#pragma unroll
    for (int u = 0; u < 2; ++u) { float s = 0.f;
#pragma unroll
        for (int j = 0; j < 16; ++j) s += v[u][j];
        const float mean = wave_sum(s) * (1.f / 1024.f); float q = 0.f;
#pragma unroll
        for (int j = 0; j < 16; ++j) { v[u][j] -= mean; q += v[u][j] * v[u][j]; }
        const float rstd = rsqrtf(wave_sum(q) * (1.f / 1024.f) + LN_EPS);
        float y[16];
#pragma unroll
        for (int j = 0; j < 16; ++j) y[j] = v[u][j] * rstd * gg[j] + bb[j];
        u32x4 o0, o1;
        o0.x = cvt_pk_bf16(y[0], y[1]); o0.y = cvt_pk_bf16(y[2], y[3]); o0.z = cvt_pk_bf16(y[4], y[5]); o0.w = cvt_pk_bf16(y[6], y[7]);
        o1.x = cvt_pk_bf16(y[8], y[9]); o1.y = cvt_pk_bf16(y[10], y[11]); o1.z = cvt_pk_bf16(y[12], y[13]); o1.w = cvt_pk_bf16(y[14], y[15]);
        bf16_t* xp = (u ? x1 : x0) + lane * 16; *(u32x4*)xp = o0; *(u32x4*)(xp + 8) = o1; }
}

__device__ __forceinline__ void ln2_rows_bf16(const bf16_t* z0, const bf16_t* z1, float* o0, float* o1, const float* g, const float* b, int lane) {
    float v[2][16];
#pragma unroll
    for (int u = 0; u < 2; ++u) { const bf16_t* zp = (u ? z1 : z0) + lane * 16; const u32x4 a = *(const u32x4*)zp, c = *(const u32x4*)(zp + 8);
        v[u][0] = bf_lo(a.x); v[u][1] = bf_hi(a.x); v[u][2] = bf_lo(a.y); v[u][3] = bf_hi(a.y); v[u][4] = bf_lo(a.z); v[u][5] = bf_hi(a.z); v[u][6] = bf_lo(a.w); v[u][7] = bf_hi(a.w);
        v[u][8] = bf_lo(c.x); v[u][9] = bf_hi(c.x); v[u][10] = bf_lo(c.y); v[u][11] = bf_hi(c.y); v[u][12] = bf_lo(c.z); v[u][13] = bf_hi(c.z); v[u][14] = bf_lo(c.w); v[u][15] = bf_hi(c.w); }
#pragma unroll
    for (int u = 0; u < 2; ++u) { float s = 0.f;
#pragma unroll
        for (int j = 0; j < 16; ++j) s += v[u][j];
        const float mean = wave_sum(s) * (1.f / 1024.f); float q = 0.f;
#pragma unroll
        for (int j = 0; j < 16; ++j) { v[u][j] -= mean; q += v[u][j] * v[u][j]; }
        const float rstd = rsqrtf(wave_sum(q) * (1.f / 1024.f) + LN_EPS);
        float* op = (u ? o1 : o0) + lane * 16;
#pragma unroll
        for (int k = 0; k < 4; ++k) { const f32x4 g4 = *(const f32x4*)(g + lane * 16 + 4 * k), b4 = *(const f32x4*)(b + lane * 16 + 4 * k);
            *(f32x4*)(op + 4 * k) = (f32x4){v[u][4 * k] * rstd * g4[0] + b4[0], v[u][4 * k + 1] * rstd * g4[1] + b4[1], v[u][4 * k + 2] * rstd * g4[2] + b4[2], v[u][4 * k + 3] * rstd * g4[3] + b4[3]}; } }
}

__device__ __forceinline__ void conv_pass(bf16_t* HH, const float* cw, const float* cb, int gt, int nthreads) {
    for (int task = gt; task < 352 * 1024; task += nthreads) {
        const int strip = task % 352, rb = task / 352, c0 = strip * 8; const size_t r0 = (size_t)rb * 32; const int t0 = (int)(r0 & (SEQ - 1));
        float w0[8], w1[8], w2[8], bb[8], gm2[8], gm1[8];
#pragma unroll
        for (int j = 0; j < 8; ++j) { w0[j] = cw[c0 + j]; w1[j] = cw[DFF + c0 + j]; w2[j] = cw[2 * DFF + c0 + j]; bb[j] = cb[c0 + j]; gm2[j] = 0.f; gm1[j] = 0.f; }
        if (t0 != 0) { const u32x4 a = *(const u32x4*)(HH + (r0 - 2) * 5632 + c0), b = *(const u32x4*)(HH + (r0 - 1) * 5632 + c0);
            gm2[0] = bf_lo(a.x); gm2[1] = bf_hi(a.x); gm2[2] = bf_lo(a.y); gm2[3] = bf_hi(a.y); gm2[4] = bf_lo(a.z); gm2[5] = bf_hi(a.z); gm2[6] = bf_lo(a.w); gm2[7] = bf_hi(a.w);
            gm1[0] = bf_lo(b.x); gm1[1] = bf_hi(b.x); gm1[2] = bf_lo(b.y); gm1[3] = bf_hi(b.y); gm1[4] = bf_lo(b.z); gm1[5] = bf_hi(b.z); gm1[6] = bf_lo(b.w); gm1[7] = bf_hi(b.w); }
#pragma unroll 8
        for (int rr = 0; rr < 32; ++rr) { bf16_t* rp = HH + (r0 + rr) * 5632 + c0;
            const u32x4 a = *(const u32x4*)rp, vv = *(const u32x4*)(rp + DFF);
            const float gc[8] = {bf_lo(a.x), bf_hi(a.x), bf_lo(a.y), bf_hi(a.y), bf_lo(a.z), bf_hi(a.z), bf_lo(a.w), bf_hi(a.w)};
            const float vl[8] = {bf_lo(vv.x), bf_hi(vv.x), bf_lo(vv.y), bf_hi(vv.y), bf_lo(vv.z), bf_hi(vv.z), bf_lo(vv.w), bf_hi(vv.w)};
            float o[8];
#pragma unroll
            for (int j = 0; j < 8; ++j) { const float y = w0[j] * gm2[j] + w1[j] * gm1[j] + w2[j] * gc[j] + bb[j]; o[j] = geluf_(y) * vl[j]; gm2[j] = gm1[j]; gm1[j] = gc[j]; }
            u32x4 ow; ow.x = cvt_pk_bf16(o[0], o[1]); ow.y = cvt_pk_bf16(o[2], o[3]); ow.z = cvt_pk_bf16(o[4], o[5]); ow.w = cvt_pk_bf16(o[6], o[7]);
            *(u32x4*)(rp + DFF) = ow; }
    }
}

struct Args { const float* in[21]; float* out; unsigned char* ws; };

typedef const Args __attribute__((address_space(4))) * ArgsP;
__device__ __forceinline__ ArgsP get_args() { ArgsP p = (ArgsP)__builtin_amdgcn_kernarg_segment_ptr(); asm volatile("" : "+s"(p)); return p; }
#define WSP(T, off) ((T*)(ap->ws + (off)))

#define XB_TMO      128
#define XB_XCNT(j)  (256  + 64 * (j))
#define XB_XSUB(j)  (1280 + 64 * (j))
#define XB_XGEN(j)  (2304 + 64 * (j))
#define XB_TOP      3328
#define XB_TOPGEN   3392
#define XCD_BAR_WORDS 3456
#define XB_SPIN_CAP (1u << 22)
__device__ __forceinline__ unsigned xb_ld(unsigned* p)              { return __hip_atomic_load(p, __ATOMIC_RELAXED, __HIP_MEMORY_SCOPE_AGENT); }
__device__ __forceinline__ unsigned xb_add(unsigned* p, unsigned v) { return __hip_atomic_fetch_add(p, v, __ATOMIC_RELAXED, __HIP_MEMORY_SCOPE_AGENT); }
__device__ __forceinline__ unsigned xb_xcc_id() { return (unsigned)__builtin_amdgcn_s_getreg((3 << 11) | 20) & 0xFu; }
#define XB_SPIN(cond, bar) do { unsigned _sp = 0; while (cond) { __builtin_amdgcn_s_sleep(1); \
    if ((++_sp & 255u) == 0u) { if (xb_ld(&(bar)[XB_TMO])) break; if (_sp > XB_SPIN_CAP) { atomicAdd(&(bar)[XB_TMO], 1u); break; } } } } while (0)
struct XcdBarrier { unsigned* bar; unsigned x; volatile LAS unsigned* st; };
__device__ __forceinline__ XcdBarrier xcd_barrier_post(unsigned* bar, volatile LAS unsigned* st) {
    XcdBarrier b; b.bar = bar; b.x = xb_xcc_id(); b.st = st;
    if (threadIdx.x == 0) (void)xb_add(&bar[XB_XCNT(b.x)], 1u);
    return b;
}
__device__ __forceinline__ void xcd_barrier_complete(unsigned* bar, unsigned x, unsigned& nloc, unsigned& nx) {
    const unsigned Gn = gridDim.x * gridDim.y * gridDim.z;
    unsigned sum, cnt, mine, sp = 0u;
    for (;;) {
        sum = 0u; cnt = 0u; mine = 0u;
#pragma unroll
        for (unsigned j = 0; j < 16; ++j) { const unsigned c = xb_ld(&bar[XB_XCNT(j)]); sum += c; cnt += (c > 0u) ? 1u : 0u; mine = (j == x) ? c : mine; }
        if (sum == Gn) break;
        __builtin_amdgcn_s_sleep(1);
        if ((++sp & 255u) == 0u) { if (xb_ld(&bar[XB_TMO])) break; if (sp > XB_SPIN_CAP) { atomicAdd(&bar[XB_TMO], 1u); break; } }
    }
    nloc = mine > 0u ? mine : 1u; nx = cnt > 0u ? cnt : 1u;
}
__device__ __forceinline__ void xcd_barrier(const XcdBarrier& b, const bool leader) {
    asm volatile("s_waitcnt vmcnt(0)" ::: "memory");
    __syncthreads();
    if (leader) {
        unsigned* bar = b.bar;
        __builtin_amdgcn_s_waitcnt(0);
        unsigned nloc = b.st[0], nx = b.st[1];
        if (nloc == 0u) { xcd_barrier_complete(bar, b.x, nloc, nx); b.st[0] = nloc; b.st[1] = nx; }
        const unsigned old = xb_add(&bar[XB_XSUB(b.x)], 1u);
        const unsigned gen = old / nloc;
        if (old + 1u == (gen + 1u) * nloc) {
            __builtin_amdgcn_fence(__ATOMIC_RELEASE, "agent");
            asm volatile("s_waitcnt vmcnt(0)" ::: "memory");
            const unsigned og = xb_add(&bar[XB_TOP], 1u);
            const unsigned tg = og / nx;
            if (og + 1u == (tg + 1u) * nx) xb_add(&bar[XB_TOPGEN], 1u);
            else XB_SPIN(xb_ld(&bar[XB_TOPGEN]) == tg, bar);
            __builtin_amdgcn_fence(__ATOMIC_ACQUIRE, "agent");
            xb_add(&bar[XB_XGEN(b.x)], 1u);
            asm volatile("s_waitcnt vmcnt(0)" ::: "memory");
        } else {
            XB_SPIN(xb_ld(&bar[XB_XGEN(b.x)]) == gen, bar);
            __builtin_amdgcn_fence(__ATOMIC_ACQUIRE, "agent");
            asm volatile("s_waitcnt vmcnt(0)" ::: "memory");
        }
    }
    __syncthreads();
}
#define SYNC() do { XcdBarrier xb_; xb_.bar = (unsigned*)get_args()->ws; xb_.x = xb_xcc_id(); xb_.st = (volatile LAS unsigned*)(lds + LDS_BYTES - 16); xcd_barrier(xb_, wv == 0 && lane_id() == 0); } while (0)
__global__ void __launch_bounds__(512, 2) fwd_kernel(Args a_unused) {
    extern __shared__ __attribute__((aligned(16))) unsigned char lds_raw[];
    LAS unsigned char* lds = (LAS unsigned char*)lds_raw;
    if (gridDim.x == 0x7fffffffu) cg::this_grid().sync();
    if (threadIdx.x < 4) ((volatile LAS unsigned*)(lds + LDS_BYTES - 16))[threadIdx.x] = 0u;
    __syncthreads();
    (void)xcd_barrier_post((unsigned*)get_args()->ws, (volatile LAS unsigned*)(lds + LDS_BYTES - 16));
    const int wv = __builtin_amdgcn_readfirstlane((int)threadIdx.x >> 6);
#define lane (lane_id())
#define gt ((int)(blockIdx.x * 512 + wv * 64 + lane_id()))
#define wave (wv)
#define G ((int)gridDim.x)
#define bx ((int)blockIdx.x)
#define nthreads (G * 512)
#define gw (bx * 8 + wave)
#define NGW (G * 8)

    {
        ArgsP ap = get_args();
        const float* w_in = ap->in[2]; const float* w_branch = ap->in[9]; const float* w_out = ap->in[10]; const float* w_up = ap->in[13]; const float* w_down = ap->in[16]; const float* w_pp = ap->in[19]; const float* w_pg = ap->in[20];
        LAS float* scr = (LAS float*)(lds + wave * 16384);
        constexpr int I_IN = 16 * 256, I_SQ = 16 * 32, I_UP = 16 * 176, I_DN = 44 * 32, I_PP = 4 * 32;
        constexpr int NITEMS = I_IN + 4 * I_SQ + I_UP + I_DN + I_PP;
        for (int it = gw; it < NITEMS; it += NGW) {
            int r = it;
            if (r < I_IN) { const int nb = r % 256, sec = nb >> 5;
                const int nsec = sec == 0 ? 4 : sec == 1 ? 5 : sec == 2 ? 0 : sec == 3 ? 1 : sec == 4 ? 2 : sec == 5 ? 3 : sec;
                p0_transpose_item(w_in, 1024, 8192, WSP(bf16_t, WS_WIN), (nsec - sec) * 1024, scr, r, lane); continue; } r -= I_IN;
            if (r < I_SQ) { p0_transpose_item(w_branch, 1024, 1024, WSP(bf16_t, WS_WA), 0, scr, r, lane); continue; } r -= I_SQ;
            if (r < I_SQ) { p0_transpose_item(w_branch + 1024 * 1024, 1024, 1024, WSP(bf16_t, WS_WB), 0, scr, r, lane); continue; } r -= I_SQ;
            if (r < I_SQ) { p0_transpose_item(w_out, 1024, 1024, WSP(bf16_t, WS_WOUT), 0, scr, r, lane); continue; } r -= I_SQ;
            if (r < I_SQ) { p0_transpose_item(w_pg, 1024, 1024, WSP(bf16_t, WS_WPG), 0, scr, r, lane); continue; } r -= I_SQ;
            if (r < I_UP) { p0_transpose_item(w_up, 1024, 5632, WSP(bf16_t, WS_WUP), 0, scr, r, lane); continue; } r -= I_UP;
            if (r < I_DN) { p0_transpose_item(w_down, 2816, 1024, WSP(bf16_t, WS_WDN), 0, scr, r, lane); continue; } r -= I_DN;
            p0_transpose_item(w_pp, 256, 1024, WSP(bf16_t, WS_WPP), 0, scr, r, lane);
        }
        cvt_f32_bf16(ap->in[0], WSP(bf16_t, WS_XBF), (size_t)M * D / 8, (size_t)gt, (size_t)nthreads);
        cvt_f32_bf16(ap->in[1], WSP(bf16_t, WS_PBF), (size_t)M * PLE / 8, (size_t)gt, (size_t)nthreads);
        if (gt < 1024) { const float* lbl = ap->in[7]; WSP(float, WS_LB)[gt] = sigmoidf_(lbl[gt] - lbl[1024 + gt]); }
    }
    SYNC();

    {
        ArgsP ap = get_args();
        pg8::Gemm g{WSP(bf16_t, WS_XBF), WSP(bf16_t, WS_WIN), M, 4096, 1024, 1024}; pg8::StaticOrder S; S.init(M, 4096, G, bx);
        pg8::EpiSec E{WSP(bf16_t, WS_Q), (size_t)32 * MiB, pg8::ACT_SILU | (pg8::ACT_LOGF << 4) | (pg8::ACT_NONE << 8) | (pg8::ACT_SILU << 12), 1024, 1024, WSP(float, WS_LB)};
        pg8::gemm_phase<pg8::EpiSec>(lds, g, S, E, wv);
    }
    SYNC();

    { ArgsP ap = get_args();
      for (int item = bx; item < 4096; item += 2 * G) { const int itemB = item + G < 4096 ? item + G : item;
        hgrn_pass_b2(lds, WSP(_Float16, WS_LOGF), WSP(bf16_t, WS_I), WSP(bf16_t, WS_U), WSP(float, WS_DTAB), item, itemB, wv); } }
    SYNC();
    { ArgsP ap = get_args(); hgrn_scan(WSP(bf16_t, WS_U), WSP(float, WS_DTAB), gt, nthreads); }
    SYNC();
    { ArgsP ap = get_args();
      for (int item = bx; item < 4096; item += G) hgrn_pass_ad(lds, WSP(bf16_t, WS_Q), WSP(_Float16, WS_LOGF), WSP(bf16_t, WS_I), WSP(bf16_t, WS_OG), WSP(bf16_t, WS_U), ap->in[8], item, wv); }
    SYNC();

    {
        ArgsP ap = get_args();
        pg8::Gemm g{WSP(bf16_t, WS_XBF), WSP(bf16_t, WS_WIN + 8 * MiB), M, 4096, 1024, 1024}; pg8::StaticOrder S; S.init(M, 4096, G, bx);
        pg8::EpiSec E{WSP(bf16_t, WS_LOGF), (size_t)32 * MiB, pg8::ACT_GELU | (pg8::ACT_GELU << 4) | (pg8::ACT_SIGM << 8) | (pg8::ACT_SIGM << 12), 1024, 1024, WSP(float, WS_LB)};
        pg8::gemm_phase<pg8::EpiSec>(lds, g, S, E, wv);
    }
    SYNC();

    { ArgsP ap = get_args();
      for (int nb = bx; nb < 256; nb += G) sgu_item(lds, WSP(bf16_t, WS_LOGF), WSP(bf16_t, WS_I), ap->in[3], ap->in[4], ap->in[5], ap->in[6], nb, wv); }
    SYNC();

    {
        ArgsP ap = get_args();
        pg8::StaticOrder S; S.init(M, 1024, G, bx);
        bf16_t* Tb = (bf16_t*)ap->out;
        { pg8::Gemm g{WSP(bf16_t, WS_LOGF), WSP(bf16_t, WS_WA), M, 1024, 1024, 1024}; pg8::EpiF32<pg8::MODE_T> E{nullptr, nullptr, WSP(bf16_t, WS_OG), nullptr, 0, Tb, 1024}; pg8::gemm_phase<pg8::EpiF32<pg8::MODE_T>>(lds, g, S, E, wv); }
        { pg8::Gemm g{WSP(bf16_t, WS_Q), WSP(bf16_t, WS_WB), M, 1024, 1024, 1024}; pg8::EpiF32<pg8::MODE_M> E{nullptr, nullptr, WSP(bf16_t, WS_U), Tb, 1024, WSP(bf16_t, WS_XBF), 1024}; pg8::gemm_phase<pg8::EpiF32<pg8::MODE_M>>(lds, g, S, E, wv); }
    }
    SYNC();

    {
        ArgsP ap = get_args();
        pg8::StaticOrder S; S.init(M, 1024, G, bx);
        pg8::Gemm g{WSP(bf16_t, WS_XBF), WSP(bf16_t, WS_WOUT), M, 1024, 1024, 1024}; pg8::EpiF32<pg8::MODE_Z> E{nullptr, ap->in[0], nullptr, nullptr, 0, (bf16_t*)ap->out, 1024}; pg8::gemm_phase<pg8::EpiF32<pg8::MODE_Z>>(lds, g, S, E, wv);
    }
    SYNC();

    { ArgsP ap = get_args(); const bf16_t* Zb = (const bf16_t*)ap->out; bf16_t* X1 = WSP(bf16_t, WS_XBF); const float* g1 = ap->in[11]; const float* b1 = ap->in[12];
      for (int m = 2 * gw; m < M; m += 2 * NGW) ln1_rows_bf16(Zb + (size_t)m * 1024, Zb + (size_t)(m + 1) * 1024, X1 + (size_t)m * 1024, X1 + (size_t)(m + 1) * 1024, g1, b1, lane); }
    SYNC();

    {
        ArgsP ap = get_args();
        pg8::Gemm g{WSP(bf16_t, WS_XBF), WSP(bf16_t, WS_WUP), M, 5632, 1024, 1024}; pg8::StaticOrder S; S.init(M, 5632, G, bx);
        pg8::EpiSec E{WSP(bf16_t, WS_HH), 0, 0, 5632, 8192, WSP(float, WS_LB)};
        pg8::gemm_phase<pg8::EpiSec>(lds, g, S, E, wv);
    }
    SYNC();

    { ArgsP ap = get_args(); conv_pass(WSP(bf16_t, WS_HH), ap->in[14], ap->in[15], gt, nthreads); }
    SYNC();

    {
        ArgsP ap = get_args();
        pg8::StaticOrder S; S.init(M, 1024, G, bx);
        bf16_t* E1 = WSP(bf16_t, WS_HH);
        { pg8::Gemm g{WSP(bf16_t, WS_PBF), WSP(bf16_t, WS_WPP), M, 1024, 256, 256}; pg8::EpiF32<pg8::MODE_E> E{nullptr, nullptr, nullptr, nullptr, 0, E1, 5632}; pg8::gemm_phase<pg8::EpiF32<pg8::MODE_E>>(lds, g, S, E, wv); }
        { pg8::Gemm g{WSP(bf16_t, WS_XBF), WSP(bf16_t, WS_WPG), M, 1024, 1024, 1024}; pg8::EpiF32<pg8::MODE_PLE> E{nullptr, nullptr, nullptr, E1, 5632, E1, 5632}; pg8::gemm_phase<pg8::EpiF32<pg8::MODE_PLE>>(lds, g, S, E, wv); }
        { pg8::Gemm g{WSP(bf16_t, WS_HH) + DFF, WSP(bf16_t, WS_WDN), M, 1024, 2816, 5632}; pg8::EpiF32<pg8::MODE_FIN> E{nullptr, nullptr, WSP(bf16_t, WS_XBF), E1, 5632, E1 + 1024, 5632}; pg8::gemm_phase<pg8::EpiF32<pg8::MODE_FIN>>(lds, g, S, E, wv); }
    }
    SYNC();

    { ArgsP ap = get_args(); float* OUT = ap->out; const bf16_t* SB = WSP(bf16_t, WS_HH) + 1024; const float* g2 = ap->in[17]; const float* b2 = ap->in[18];
      for (int m = 2 * gw; m < M; m += 2 * NGW) ln2_rows_bf16(SB + (size_t)m * 5632, SB + (size_t)(m + 1) * 5632, OUT + (size_t)m * 1024, OUT + (size_t)(m + 1) * 1024, g2, b2, lane); }
}
#undef wave
#undef G
#undef bx
#undef nthreads
#undef gw
#undef NGW
#undef lane
#undef gt
extern "C" void kernel_launch(void* const* d_in, const int* in_sizes, int n_in, void* d_out, int out_size, void* d_ws, size_t ws_size, hipStream_t stream) {
    static int grid = 0;
    if (grid == 0) {
        if (n_in != 21 || out_size != M * D || ws_size < WS_NEED) { fprintf(stderr, "kernel_launch: unexpected shapes (n_in %d out %d ws %zu)\n", n_in, out_size, ws_size); grid = -1; return; }
        int dev = 0, cus = 0, per_cu = 0;
        hipGetDevice(&dev);
        hipDeviceGetAttribute(&cus, hipDeviceAttributeMultiprocessorCount, dev);
        hipFuncSetAttribute((const void*)fwd_kernel, hipFuncAttributeMaxDynamicSharedMemorySize, LDS_BYTES);
        hipOccupancyMaxActiveBlocksPerMultiprocessor(&per_cu, (const void*)fwd_kernel, 512, LDS_BYTES);
        if (per_cu < 1) per_cu = 1;
        grid = cus * per_cu;
        (void)hipGetLastError();
    }
    if (grid < 0) return;
    if (hipMemsetAsync(d_ws, 0, 16384, stream) != hipSuccess) { fprintf(stderr, "memset failed\n"); return; }
    Args a{};
    for (int i = 0; i < 21; ++i) a.in[i] = (const float*)d_in[i];
    a.out = (float*)d_out; a.ws = (unsigned char*)d_ws;
    void* args[] = {&a};
    hipError_t e = hipLaunchCooperativeKernel((const void*)fwd_kernel, dim3(grid), dim3(512), args, LDS_BYTES, stream);
    if (e != hipSuccess) fprintf(stderr, "cooperative launch failed: %s (grid %d)\n", hipGetErrorString(e), grid);
}
```

```cpp
#include <hip/hip_runtime.h>
#include <hip/hip_cooperative_groups.h>
#include <cstdio>
#include <cstdint>
namespace cg = cooperative_groups;

#define LAS __attribute__((address_space(3)))
typedef unsigned short bf16_t;
typedef short bf16x8 __attribute__((ext_vector_type(8)));
typedef float f32x4 __attribute__((ext_vector_type(4)));
typedef float f32x2 __attribute__((ext_vector_type(2)));
typedef unsigned u32x4 __attribute__((ext_vector_type(4)));
typedef unsigned u32x2 __attribute__((ext_vector_type(2)));

constexpr int M = 32768, D = 1024, SEQ = 4096, DFF = 2816, PLE = 256;
constexpr float LN_EPS = 1e-5f, RMS_EPS = 1e-6f;
constexpr float ALPHA = 1.189207115002721f;
constexpr int LDS_BYTES = 147456;

constexpr size_t MiB = 1u << 20;
constexpr size_t WS_LB = MiB / 2;
constexpr size_t WS_WIN = 1 * MiB, WS_WA = 17 * MiB, WS_WB = 19 * MiB, WS_WOUT = 21 * MiB, WS_WUP = 23 * MiB, WS_WDN = 34 * MiB, WS_WPG = 40 * MiB, WS_WPP = 42 * MiB;
constexpr size_t WS_DTAB = 43 * MiB;
constexpr size_t WS_XBF = 48 * MiB;
constexpr size_t WS_Q = 112 * MiB;
constexpr size_t WS_LOGF = 176 * MiB;
constexpr size_t WS_I = 240 * MiB;
constexpr size_t WS_OG = 304 * MiB;
constexpr size_t WS_U = 368 * MiB;
constexpr size_t WS_HH = 112 * MiB;
constexpr size_t WS_PBF = 496 * MiB;
constexpr size_t WS_NEED = 512 * MiB;

typedef __bf16 bf16x2_t __attribute__((ext_vector_type(2)));
__device__ __forceinline__ unsigned cvt_pk_bf16(float lo, float hi) { const f32x2 v = {lo, hi}; const bf16x2_t b = __builtin_convertvector(v, bf16x2_t); return __builtin_bit_cast(unsigned, b); }
__device__ __forceinline__ float bf_lo(unsigned w) { return __uint_as_float(w << 16); }
__device__ __forceinline__ float bf_hi(unsigned w) { return __uint_as_float(w & 0xffff0000u); }
__device__ __forceinline__ float bf2f(bf16_t h) { return __uint_as_float((unsigned)h << 16); }
__device__ __forceinline__ unsigned pk_f16(float lo, float hi) { const _Float16 a = (_Float16)lo, b = (_Float16)hi; return (unsigned)__builtin_bit_cast(unsigned short, a) | ((unsigned)__builtin_bit_cast(unsigned short, b) << 16); }
__device__ __forceinline__ float h_lo(unsigned w) { return (float)__builtin_bit_cast(_Float16, (unsigned short)(w & 0xffffu)); }
__device__ __forceinline__ float h_hi(unsigned w) { return (float)__builtin_bit_cast(_Float16, (unsigned short)(w >> 16)); }
__device__ __forceinline__ float sigmoidf_(float x) { return __builtin_amdgcn_rcpf(1.0f + __expf(-x)); }
__device__ __forceinline__ float siluf_(float x) { return x * sigmoidf_(x); }
__device__ __forceinline__ float geluf_(float x) { return x * sigmoidf_(1.5957691216057308f * (x + 0.044715f * x * x * x)); }
__device__ __forceinline__ int lane_id() { int l = (int)__builtin_amdgcn_mbcnt_hi(~0u, __builtin_amdgcn_mbcnt_lo(~0u, 0u)); asm volatile("" : "+v"(l)); return l; }
__device__ __forceinline__ float shfl_xor_l(float v, int o, int l) { return __int_as_float(__builtin_amdgcn_ds_bpermute((l ^ o) << 2, __float_as_int(v))); }
__device__ __forceinline__ float wave_sum(float v) {
    const int l = lane_id();
#pragma unroll
    for (int o = 1; o < 64; o <<= 1) v += shfl_xor_l(v, o, l);
    return v;
}

namespace pg8 {
constexpr int BM = 256, BK = 64, HALF = 128, HTB = HALF * BK * 2, STAGE_BYTES = 8 * HTB, NXCD = 8, WGM = 8;
__host__ __device__ __forceinline__ int lds_byte(int r, int c) { const int st = (r >> 4) * 2 + (c >> 5), rr = r & 15, cc = c & 31, ob = rr * 64 + cc * 2; return st * 1024 + (ob ^ (((ob >> 9) & 1) << 5)); }
__host__ __device__ __forceinline__ void stage_rc(int b, int& R, int& C) { const int st = b / 1024, sb = b % 1024, swz = sb ^ (((sb >> 9) & 1) << 5); R = (st >> 1) * 16 + swz / 64; C = (st & 1) * 32 + (swz % 64) / 2; }
__host__ __device__ __forceinline__ int perm32(int rho) { const int n = rho >> 4, i = rho & 15; return 8 * (i >> 2) + 4 * n + (i & 3); }

struct Unit { int pm, pn; };
struct Gemm { const bf16_t* A; const bf16_t* Bt; int M, N, K, lda; };

struct StaticOrder {
    int nM, nN, nwg, G, c;
    __device__ void init(int M_, int N_, int G_, int c_) { nM = M_ / BM; nN = N_ / BM; nwg = nM * nN; G = G_; c = c_; }
    __device__ bool next(int i, Unit& u) const {
        const long L = (long)i * G + c; if (L >= nwg) return false;
        int wgid = (int)L; { const int q = nwg / NXCD, r = nwg % NXCD, xcd = wgid % NXCD, off = wgid / NXCD; wgid = (xcd < r ? xcd * (q + 1) : r * (q + 1) + (xcd - r) * q) + off; }
        const int nig = WGM * nN, gid = wgid / nig, fm = gid * WGM, gsz = (nM - fm) < WGM ? (nM - fm) : WGM;
        u.pm = fm + ((wgid % nig) % gsz); u.pn = (wgid % nig) / gsz; return true;
    }
};

template <class Epi>
__device__ __forceinline__ void gemm_phase(LAS unsigned char* lds, const Gemm g, const StaticOrder& S, const Epi& E, const int wv) {
    int tid_ = wv * 64 + lane_id(); asm volatile("" : "+v"(tid_));
    const int tid = tid_, wid = __builtin_amdgcn_readfirstlane(tid >> 6), lane = tid & 63, wr = wid >> 2, wc = wid & 3, fr = lane & 15, fq = lane >> 4;
    const int K = g.K, nt = K / BK, lda = g.lda;
    unsigned voffA[2], voffB[2];
#pragma unroll
    for (int i = 0; i < 2; ++i) { int R, C; stage_rc(tid * 16 + i * 8192, R, C); const int Rb = Epi::PERM ? ((R & ~31) + perm32(R & 31)) : R;
        voffA[i] = (unsigned)(R * lda + C) * 2u; voffB[i] = (unsigned)(Rb * K + C) * 2u; }
    const size_t kstep = (size_t)(BK * 2);
    const size_t hstepA = (size_t)HALF * lda * 2, hstepB = (size_t)HALF * K * 2;
    const size_t tstepA = 2 * hstepA, tstepB = 2 * hstepB;
    const unsigned ldsw = (unsigned)wid * 1024u;
    const int aoff = lds_byte(wr * 64 + fr, fq * 8), boff = lds_byte(wc * 32 + fr, fq * 8);
#define PG8_SA(b, h) (((b) * 2 + (h)) * HTB)
#define PG8_SB(b, h) ((4 + (b) * 2 + (h)) * HTB)
#define PG8_STAGE(bufoff, gbase, voff) do { _Pragma("unroll") for (int _i = 0; _i < 2; ++_i) \
        __builtin_amdgcn_global_load_lds((const unsigned*)((const char*)(gbase) + (voff)[_i]), (LAS unsigned*)(lds + (bufoff) + ldsw + _i * 8192), 16, 0, 0); } while (0)
#define PG8_LDA(dst, b, h) do { _Pragma("unroll") for (int m = 0; m < 4; ++m) _Pragma("unroll") for (int k = 0; k < 2; ++k) dst[m][k] = *(const LAS bf16x8*)(lds + PG8_SA(b, h) + aoff + m * 2048 + k * 1024); } while (0)
#define PG8_LDB(dst, b, h) do { _Pragma("unroll") for (int n = 0; n < 2; ++n) _Pragma("unroll") for (int k = 0; k < 2; ++k) dst[n][k] = *(const LAS bf16x8*)(lds + PG8_SB(b, h) + boff + n * 2048 + k * 1024); } while (0)
#define PG8_MMA(ai, bj, At, Bt) do { __builtin_amdgcn_s_setprio(1); _Pragma("unroll") for (int m = 0; m < 4; ++m) _Pragma("unroll") for (int n = 0; n < 2; ++n) _Pragma("unroll") for (int k = 0; k < 2; ++k) \
        acc[ai][bj][m][n] = __builtin_amdgcn_mfma_f32_16x16x32_bf16(Bt[n][k], At[m][k], acc[ai][bj][m][n], 0, 0, 0); __builtin_amdgcn_s_setprio(0); } while (0)
#define PG8_WAIT_V(n) asm volatile("s_waitcnt vmcnt(" #n ")" ::: "memory")
#define PG8_WAIT_L(n) asm volatile("s_waitcnt lgkmcnt(" #n ")" ::: "memory")
#define PG8_BAR __builtin_amdgcn_s_barrier()
#define PG8_SCHED __builtin_amdgcn_sched_barrier(0)
    Unit cur, nxt; int ui = 0;
    if (!S.next(0, cur)) return;
    f32x4 acc[2][2][4][2];
#pragma unroll
    for (int a = 0; a < 2; ++a)
#pragma unroll
        for (int b = 0; b < 2; ++b)
#pragma unroll
            for (int m = 0; m < 4; ++m)
#pragma unroll
                for (int n = 0; n < 2; ++n) acc[a][b][m][n] = (f32x4){0.f, 0.f, 0.f, 0.f};
    bf16x8 At[4][2], B0[2][2], B1[2][2];
    const char* cA = (const char*)g.A + (size_t)cur.pm * tstepA; const char* cB = (const char*)g.Bt + (size_t)cur.pn * tstepB;
    PG8_STAGE(PG8_SB(0, 0), cB, voffB); PG8_STAGE(PG8_SB(0, 1), cB + hstepB, voffB); PG8_STAGE(PG8_SA(0, 0), cA, voffA); PG8_STAGE(PG8_SA(0, 1), cA + hstepA, voffA);
    if (wr == 1) PG8_BAR;
    PG8_WAIT_V(2); PG8_BAR;
    PG8_STAGE(PG8_SB(1, 0), cB + kstep, voffB); PG8_STAGE(PG8_SA(1, 0), cA + kstep, voffA); PG8_STAGE(PG8_SB(1, 1), cB + hstepB + kstep, voffB);
    PG8_WAIT_V(6); PG8_BAR;
    for (;;) {
        const bool has_next = S.next(ui + 1, nxt);
        const char* nA = has_next ? (const char*)g.A + (size_t)nxt.pm * tstepA : cA; const char* nB = has_next ? (const char*)g.Bt + (size_t)nxt.pn * tstepB : cB;
        for (int t = 0; t < nt; t += 2) {
            const bool last = (t == nt - 2);
            const char* a1 = cA + (size_t)(t + 1) * kstep;
            const char* a2 = last ? nA : cA + (size_t)(t + 2) * kstep; const char* b2 = last ? nB : cB + (size_t)(t + 2) * kstep;
            const char* a3 = a2 + kstep; const char* b3 = b2 + kstep;
            PG8_LDB(B0, 0, 0); PG8_LDB(B1, 0, 1); PG8_SCHED; PG8_LDA(At, 0, 0); PG8_STAGE(PG8_SA(1, 1), a1 + hstepA, voffA);
            PG8_WAIT_V(8); PG8_WAIT_L(0); PG8_BAR; PG8_MMA(0, 0, At, B0); PG8_MMA(0, 1, At, B1); PG8_BAR; PG8_SCHED;
            PG8_LDA(At, 0, 1); PG8_STAGE(PG8_SB(0, 0), b2, voffB); PG8_STAGE(PG8_SB(0, 1), b2 + hstepB, voffB); PG8_STAGE(PG8_SA(0, 0), a2, voffA);
            PG8_WAIT_V(8); PG8_WAIT_L(0); PG8_BAR; PG8_MMA(1, 0, At, B0); PG8_MMA(1, 1, At, B1); PG8_BAR; PG8_SCHED;
            PG8_LDB(B0, 1, 0); PG8_LDB(B1, 1, 1); PG8_SCHED; PG8_LDA(At, 1, 0); PG8_STAGE(PG8_SA(0, 1), a2 + hstepA, voffA);
            PG8_WAIT_V(8); PG8_WAIT_L(0); PG8_BAR; PG8_MMA(0, 0, At, B0); PG8_MMA(0, 1, At, B1); PG8_BAR; PG8_SCHED;
            PG8_LDA(At, 1, 1); PG8_STAGE(PG8_SB(1, 0), b3, voffB); PG8_STAGE(PG8_SB(1, 1), b3 + hstepB, voffB); PG8_STAGE(PG8_SA(1, 0), a3, voffA);
            PG8_WAIT_V(8); PG8_WAIT_L(0); PG8_BAR; PG8_MMA(1, 0, At, B0); PG8_MMA(1, 1, At, B1); PG8_BAR; PG8_SCHED;
        }
        if (wr == 0) PG8_BAR;
        E(acc, cur, wr, wc, fr, fq);
        if (!has_next) break;
#pragma unroll
        for (int a = 0; a < 2; ++a)
#pragma unroll
            for (int b = 0; b < 2; ++b)
#pragma unroll
                for (int m = 0; m < 4; ++m)
#pragma unroll
                    for (int n = 0; n < 2; ++n) acc[a][b][m][n] = (f32x4){0.f, 0.f, 0.f, 0.f};
        cur = nxt; cA = nA; cB = nB; ++ui;
        if (wr == 1) PG8_BAR;
    }
    PG8_WAIT_V(0);
    PG8_BAR;
#undef PG8_SA
#undef PG8_SB
#undef PG8_STAGE
#undef PG8_LDA
#undef PG8_LDB
#undef PG8_MMA
#undef PG8_WAIT_V
#undef PG8_WAIT_L
#undef PG8_BAR
#undef PG8_SCHED
}

enum { ACT_NONE = 0, ACT_GELU = 1, ACT_SILU = 2, ACT_SIGM = 3, ACT_LOGF = 4 };
template <int ACT> __device__ __forceinline__ float act_apply(float v, float lb) {
    if (ACT == ACT_GELU) return geluf_(v);
    if (ACT == ACT_SILU) return siluf_(v);
    if (ACT == ACT_SIGM) return sigmoidf_(v);
    if (ACT == ACT_LOGF) return __logf(lb + (1.0f - lb) * sigmoidf_(v));
    return v;
}
template <int ACT> __device__ __forceinline__ void epi16_store(const f32x4 (&acc)[2][2][4][2], bf16_t* base, int ldc, int row0, int col0, const float* lbp) {
    float lbv[2][8];
#pragma unroll
    for (int bj = 0; bj < 2; ++bj)
#pragma unroll
        for (int j = 0; j < 8; ++j) lbv[bj][j] = (ACT == ACT_LOGF) ? lbp[col0 + bj * HALF + j] : 0.f;
#pragma unroll
    for (int ai = 0; ai < 2; ++ai)
#pragma unroll
        for (int m = 0; m < 4; ++m) { bf16_t* rowp = base + (size_t)(row0 + ai * HALF + m * 16) * ldc + col0;
#pragma unroll
            for (int bj = 0; bj < 2; ++bj) { f32x4 v0 = acc[ai][bj][m][0], v1 = acc[ai][bj][m][1];
                asm volatile("; act %c2" : "+v"(v0), "+v"(v1) : "i"(ACT));
                float o[8];
#pragma unroll
                for (int j = 0; j < 4; ++j) { o[j] = act_apply<ACT>(v0[j], lbv[bj][j]); o[4 + j] = act_apply<ACT>(v1[j], lbv[bj][4 + j]); }
                u32x4 w;
                if (ACT == ACT_LOGF) { w.x = pk_f16(o[0], o[1]); w.y = pk_f16(o[2], o[3]); w.z = pk_f16(o[4], o[5]); w.w = pk_f16(o[6], o[7]); }
                else { w.x = cvt_pk_bf16(o[0], o[1]); w.y = cvt_pk_bf16(o[2], o[3]); w.z = cvt_pk_bf16(o[4], o[5]); w.w = cvt_pk_bf16(o[6], o[7]); }
                *(u32x4*)(rowp + bj * HALF) = w; } }
}
struct EpiSec {
    static constexpr bool PERM = true;
    bf16_t* d0; size_t sec_stride; int acts; int ldc, sec_cols; const float* lb;
    __device__ __forceinline__ void operator()(const f32x4 (&acc)[2][2][4][2], const Unit& u, int wr, int wc, int fr, int fq) const {
        { int t_ = lane_id(); asm volatile("" : "+v"(t_)); fr = t_ & 15; fq = (t_ >> 4) & 3; }
        const int colt = u.pn * BM, sec = colt / sec_cols, colin = colt - sec * sec_cols;
        bf16_t* base = d0 + (size_t)sec * sec_stride;
        const int a = (acts >> (4 * sec)) & 15;
        const int row0 = u.pm * BM + wr * 64 + fr, col0 = colin + wc * 32 + 8 * fq;
        if (a == ACT_NONE) epi16_store<ACT_NONE>(acc, base, ldc, row0, col0, lb);
        else if (a == ACT_GELU) epi16_store<ACT_GELU>(acc, base, ldc, row0, col0, lb);
        else if (a == ACT_SILU) epi16_store<ACT_SILU>(acc, base, ldc, row0, col0, lb);
        else if (a == ACT_SIGM) epi16_store<ACT_SIGM>(acc, base, ldc, row0, col0, lb);
        else epi16_store<ACT_LOGF>(acc, base, ldc, row0, col0, lb);
    }
};
enum { MODE_T = 0, MODE_M = 1, MODE_Z = 2, MODE_E = 3, MODE_PLE = 4, MODE_FIN = 5 };
__device__ __forceinline__ f32x4 ld_bf4(const bf16_t* p) { const u32x2 w = *(const u32x2*)p; return (f32x4){bf_lo(w.x), bf_hi(w.x), bf_lo(w.y), bf_hi(w.y)}; }
__device__ __forceinline__ void st_bf4(bf16_t* p, const f32x4 o) { u32x2 w; w.x = cvt_pk_bf16(o[0], o[1]); w.y = cvt_pk_bf16(o[2], o[3]); *(u32x2*)p = w; }
template <int MODE> struct EpiF32 {
    static constexpr bool PERM = false;
    float* out; const float* in; const bf16_t* g; const bf16_t* ib; int ldib; bf16_t* ob; int ldob;
    __device__ __forceinline__ void operator()(const f32x4 (&acc)[2][2][4][2], const Unit& u, int wr, int wc, int fr, int fq) const {
        { int t_ = lane_id(); asm volatile("" : "+v"(t_)); fr = t_ & 15; fq = (t_ >> 4) & 3; }
        const int row0 = u.pm * BM + wr * 64 + fr, col0 = u.pn * BM + wc * 32 + 4 * fq;
#pragma unroll
        for (int ai = 0; ai < 2; ++ai)
#pragma unroll
            for (int m = 0; m < 4; ++m) { const size_t r = (size_t)(row0 + ai * HALF + m * 16);
#pragma unroll
                for (int bj = 0; bj < 2; ++bj)
#pragma unroll
                    for (int n = 0; n < 2; ++n) { const int c = col0 + bj * HALF + n * 16; const f32x4 v = acc[ai][bj][m][n];
                        if (MODE == MODE_T) { st_bf4(ob + r * ldob + c, v * ld_bf4(g + r * 1024 + c)); }
                        else if (MODE == MODE_M) { st_bf4(ob + r * ldob + c, ld_bf4(ib + r * ldib + c) + v * ld_bf4(g + r * 1024 + c)); }
                        else if (MODE == MODE_Z) { const f32x4 xx = *(const f32x4*)(in + r * 1024 + c); st_bf4(ob + r * ldob + c, xx * ALPHA + v); }
                        else if (MODE == MODE_E) { st_bf4(ob + r * ldob + c, v); }
                        else if (MODE == MODE_PLE) { const f32x4 e = ld_bf4(ib + r * ldib + c); st_bf4(ob + r * ldob + c, (f32x4){sigmoidf_(v[0]) * e[0], sigmoidf_(v[1]) * e[1], sigmoidf_(v[2]) * e[2], sigmoidf_(v[3]) * e[3]}); }
                        else { const f32x4 x1 = ld_bf4(g + r * 1024 + c), pl = ld_bf4(ib + r * ldib + c); *(f32x4*)(out + r * 1024 + c) = x1 * ALPHA + pl + v; }
                    }
                asm volatile("" ::: "memory"); }
    }
};
}

__device__ __forceinline__ void p0_transpose_item(const float* W, int K, int N, bf16_t* WT, int row_off, LAS float* scr, int item, int lane) {
    const int nblk = N / 32, kb = item / nblk, nb = item % nblk, k0 = 64 * kb, n0 = 32 * nb;
#pragma unroll 8
    for (int i = 0; i < 32; ++i) { const int kk = 2 * i + (lane >> 5); scr[kk * 33 + (lane & 31)] = W[(size_t)(k0 + kk) * N + n0 + (lane & 31)]; }
    asm volatile("s_waitcnt lgkmcnt(0)" ::: "memory");
    const int c = lane & 7;
#pragma unroll
    for (int j = 0; j < 4; ++j) { const int n = (lane >> 3) + 8 * j; const LAS float* s = scr + (8 * c) * 33 + n;
        u32x4 o; o.x = cvt_pk_bf16(s[0 * 33], s[1 * 33]); o.y = cvt_pk_bf16(s[2 * 33], s[3 * 33]); o.z = cvt_pk_bf16(s[4 * 33], s[5 * 33]); o.w = cvt_pk_bf16(s[6 * 33], s[7 * 33]);
        *(u32x4*)(WT + (size_t)(row_off + n0 + n) * K + k0 + 8 * c) = o; }
    asm volatile("s_waitcnt lgkmcnt(0)" ::: "memory");
}
__device__ __forceinline__ void cvt_f32_bf16(const float* src, bf16_t* dst, size_t nvec, size_t gt, size_t nthreads) {
    size_t i = gt;
    for (; i + 3 * nthreads < nvec; i += 4 * nthreads) { f32x4 a[4], b[4];
#pragma unroll
        for (int u = 0; u < 4; ++u) { a[u] = *(const f32x4*)(src + (i + u * nthreads) * 8); b[u] = *(const f32x4*)(src + (i + u * nthreads) * 8 + 4); }
#pragma unroll
        for (int u = 0; u < 4; ++u) { u32x4 o; o.x = cvt_pk_bf16(a[u][0], a[u][1]); o.y = cvt_pk_bf16(a[u][2], a[u][3]); o.z = cvt_pk_bf16(b[u][0], b[u][1]); o.w = cvt_pk_bf16(b[u][2], b[u][3]); *(u32x4*)(dst + (i + u * nthreads) * 8) = o; } }
    for (; i < nvec; i += nthreads) { const f32x4 a = *(const f32x4*)(src + i * 8), b = *(const f32x4*)(src + i * 8 + 4);
        u32x4 o; o.x = cvt_pk_bf16(a[0], a[1]); o.y = cvt_pk_bf16(a[2], a[3]); o.z = cvt_pk_bf16(b[0], b[1]); o.w = cvt_pk_bf16(b[2], b[3]); *(u32x4*)(dst + i * 8) = o; }
}

__device__ __forceinline__ bf16x8 ldfrag(const LAS bf16_t* base, int row, int ld, int k) { return *(const LAS bf16x8*)(base + row * ld + k); }

__device__ __forceinline__ void hgrn_pass_b2(LAS unsigned char* lds, const _Float16* LOGF, const bf16_t* I, bf16_t* U, float* Dtab, int itemA, int itemB, const int wv) {
    int tid_ = wv * 64 + lane_id(); asm volatile("" : "+v"(tid_)); const int tid = tid_, lane = tid & 63, w = tid >> 6;
    const int e = tid & 127, part = tid >> 7;
    float lf[2][16], cum[2][16]; unsigned short iv[2][16]; float sum[2];
#pragma unroll
    for (int u = 0; u < 2; ++u) { const int item = u ? itemB : itemA; const int c = item & 63, bh = item >> 6, h = bh & 7, b = bh >> 3; const size_t r0 = (size_t)b * SEQ + (size_t)c * 64;
#pragma unroll
        for (int j = 0; j < 16; ++j) { const size_t off = (r0 + 16 * part + j) * 1024 + h * 128 + e; lf[u][j] = (float)LOGF[off]; iv[u][j] = I[off]; } }
#pragma unroll
    for (int u = 0; u < 2; ++u) { LAS bf16_t* kT = (LAS bf16_t*)(lds + u * 38912); LAS bf16_t* iT = kT + 128 * 72; LAS float* tot = (LAS float*)(iT + 128 * 72);
        float s = 0.f;
#pragma unroll
        for (int j = 0; j < 16; ++j) { s += lf[u][j]; cum[u][j] = s; }
        sum[u] = s; tot[part * 128 + e] = s;
        u32x4 w0, w1;
        w0.x = iv[u][0] | ((unsigned)iv[u][1] << 16); w0.y = iv[u][2] | ((unsigned)iv[u][3] << 16); w0.z = iv[u][4] | ((unsigned)iv[u][5] << 16); w0.w = iv[u][6] | ((unsigned)iv[u][7] << 16);
        w1.x = iv[u][8] | ((unsigned)iv[u][9] << 16); w1.y = iv[u][10] | ((unsigned)iv[u][11] << 16); w1.z = iv[u][12] | ((unsigned)iv[u][13] << 16); w1.w = iv[u][14] | ((unsigned)iv[u][15] << 16);
        *(LAS u32x4*)(iT + e * 72 + 16 * part) = w0; *(LAS u32x4*)(iT + e * 72 + 16 * part + 8) = w1; }
    __syncthreads();
#pragma unroll
    for (int u = 0; u < 2; ++u) { const int item = u ? itemB : itemA; LAS bf16_t* kT = (LAS bf16_t*)(lds + u * 38912); LAS bf16_t* iT = kT + 128 * 72; LAS float* tot = (LAS float*)(iT + 128 * 72);
        float off = 0.f, total = 0.f;
#pragma unroll
        for (int p = 0; p < 4; ++p) { const float t = tot[p * 128 + e]; if (p < part) off += t; total += t; }
        float kp[16];
#pragma unroll
        for (int j = 0; j < 16; ++j) kp[j] = (1.0f - __expf(lf[u][j])) * __expf(total - (off + cum[u][j]));
        u32x4 w0, w1;
        w0.x = cvt_pk_bf16(kp[0], kp[1]); w0.y = cvt_pk_bf16(kp[2], kp[3]); w0.z = cvt_pk_bf16(kp[4], kp[5]); w0.w = cvt_pk_bf16(kp[6], kp[7]);
        w1.x = cvt_pk_bf16(kp[8], kp[9]); w1.y = cvt_pk_bf16(kp[10], kp[11]); w1.z = cvt_pk_bf16(kp[12], kp[13]); w1.w = cvt_pk_bf16(kp[14], kp[15]);
        *(LAS u32x4*)(kT + e * 72 + 16 * part) = w0; *(LAS u32x4*)(kT + e * 72 + 16 * part + 8) = w1;
        if (part == 0) Dtab[(size_t)item * 128 + e] = __expf(total); }
    __syncthreads();
#pragma unroll
    for (int u = 0; u < 2; ++u) { const int item = u ? itemB : itemA; const LAS bf16_t* kT = (const LAS bf16_t*)(lds + u * 38912); const LAS bf16_t* iT = kT + 128 * 72;
        bf16x8 yf[2];
#pragma unroll
        for (int ks = 0; ks < 2; ++ks) yf[ks] = ldfrag(iT, 16 * w + (lane & 15), 72, ks * 32 + (lane >> 4) * 8);
        bf16_t* Ub = U + (size_t)item * 16384 + (size_t)(16 * w + (lane & 15)) * 128 + (lane >> 4) * 4;
#pragma unroll
        for (int te = 0; te < 8; ++te) { f32x4 acc = {0.f, 0.f, 0.f, 0.f};
#pragma unroll
            for (int ks = 0; ks < 2; ++ks) { const bf16x8 xf = ldfrag(kT, 16 * te + (lane & 15), 72, ks * 32 + (lane >> 4) * 8); acc = __builtin_amdgcn_mfma_f32_16x16x32_bf16(xf, yf[ks], acc, 0, 0, 0); }
            u32x2 o; o.x = cvt_pk_bf16(acc[0], acc[1]); o.y = cvt_pk_bf16(acc[2], acc[3]); *(u32x2*)(Ub + 16 * te) = o; } }
    __syncthreads();
}

__device__ __forceinline__ void hgrn_scan(bf16_t* U, const float* Dtab, int gt, int nthreads) {
    for (int idx = gt; idx < 64 * 2048; idx += nthreads) {
        const int bh = idx >> 11, el = (idx & 2047) * 8, e8 = el & 127;
        float S[8];
#pragma unroll
        for (int j = 0; j < 8; ++j) S[j] = 0.f;
#pragma unroll 8
        for (int c = 0; c < 64; ++c) { const size_t item = (size_t)bh * 64 + c;
            u32x4* up = (u32x4*)(U + item * 16384 + el); const u32x4 uv = *up;
            const f32x4 d0 = *(const f32x4*)(Dtab + item * 128 + e8), d1 = *(const f32x4*)(Dtab + item * 128 + e8 + 4);
            u32x4 o; o.x = cvt_pk_bf16(S[0], S[1]); o.y = cvt_pk_bf16(S[2], S[3]); o.z = cvt_pk_bf16(S[4], S[5]); o.w = cvt_pk_bf16(S[6], S[7]); *up = o;
            S[0] = d0[0] * S[0] + bf_lo(uv.x); S[1] = d0[1] * S[1] + bf_hi(uv.x); S[2] = d0[2] * S[2] + bf_lo(uv.y); S[3] = d0[3] * S[3] + bf_hi(uv.y);
            S[4] = d1[0] * S[4] + bf_lo(uv.z); S[5] = d1[1] * S[5] + bf_hi(uv.z); S[6] = d1[2] * S[6] + bf_lo(uv.w); S[7] = d1[3] * S[7] + bf_hi(uv.w); }
    }
}

__device__ __forceinline__ void hgrn_pass_ad(LAS unsigned char* lds, bf16_t* Q, const _Float16* LOGF, const bf16_t* I, const bf16_t* OG, const bf16_t* U, const float* gnorm, int item, const int wv) {
    int tid_ = wv * 64 + lane_id(); asm volatile("" : "+v"(tid_)); const int tid = tid_, lane = tid & 63, w = tid >> 6;
    const int c = item & 63, bh = item >> 6, h = bh & 7, b = bh >> 3;
    const size_t r0 = (size_t)b * SEQ + (size_t)c * 64;
    LAS bf16_t* qs = (LAS bf16_t*)lds;
    LAS bf16_t* ks_ = (LAS bf16_t*)(lds + 17408);
    LAS bf16_t* iT = (LAS bf16_t*)(lds + 34816);
    LAS bf16_t* ST = (LAS bf16_t*)(lds + 53248);
    LAS bf16_t* at = (LAS bf16_t*)(lds + 88064);
    LAS float* Cb = (LAS float*)(lds + 97280);
    LAS float* tot = (LAS float*)(lds + 131072);
    const int e = tid & 127, part = tid >> 7;
    u32x4 q8h[2], l8h[2];
#pragma unroll
    for (int rr = 0; rr < 2; ++rr) { const size_t off = (r0 + (tid >> 4) + 32 * rr) * 1024 + h * 128 + (tid & 15) * 8; q8h[rr] = *(const u32x4*)(Q + off); l8h[rr] = *(const u32x4*)((const bf16_t*)LOGF + off); }
    const size_t ogoff = (r0 + (tid >> 3)) * 1024 + h * 128 + (tid & 7) * 16;
    const u32x4 g0 = *(const u32x4*)(OG + ogoff), g1 = *(const u32x4*)(OG + ogoff + 8);
    float cum[16];
    { float s = 0.f; unsigned short iv[16];
#pragma unroll
      for (int j = 0; j < 16; ++j) { const size_t off = (r0 + 16 * part + j) * 1024 + h * 128 + e; s += (float)LOGF[off]; cum[j] = s; iv[j] = I[off]; }
      tot[part * 128 + e] = s;
      u32x4 w0, w1;
      w0.x = iv[0] | ((unsigned)iv[1] << 16); w0.y = iv[2] | ((unsigned)iv[3] << 16); w0.z = iv[4] | ((unsigned)iv[5] << 16); w0.w = iv[6] | ((unsigned)iv[7] << 16);
      w1.x = iv[8] | ((unsigned)iv[9] << 16); w1.y = iv[10] | ((unsigned)iv[11] << 16); w1.z = iv[12] | ((unsigned)iv[13] << 16); w1.w = iv[14] | ((unsigned)iv[15] << 16);
      *(LAS u32x4*)(iT + e * 72 + 16 * part) = w0; *(LAS u32x4*)(iT + e * 72 + 16 * part + 8) = w1; }
#pragma unroll
    for (int k = 0; k < 4; ++k) { const int idx = tid + 512 * k, v = idx >> 4, e8 = (idx & 15) * 8;
        *(LAS u32x4*)(ST + v * 136 + e8) = *(const u32x4*)(U + (size_t)item * 16384 + v * 128 + e8); }
    __syncthreads();
    { float off = 0.f;
#pragma unroll
      for (int p = 0; p < 3; ++p) { const float t = tot[p * 128 + e]; if (p < part) off += t; }
#pragma unroll
      for (int j = 0; j < 16; ++j) Cb[(16 * part + j) * 132 + e] = off + cum[j]; }
    __syncthreads();
#pragma unroll
    for (int rr = 0; rr < 2; ++rr) { const int t = (tid >> 4) + 32 * rr, e8 = (tid & 15) * 8;
        const u32x4 q8 = q8h[rr]; const u32x4 l8 = l8h[rr];
        const f32x4 c0 = *(const LAS f32x4*)(Cb + t * 132 + e8), c1 = *(const LAS f32x4*)(Cb + t * 132 + e8 + 4);
        float qv[8] = {bf_lo(q8.x), bf_hi(q8.x), bf_lo(q8.y), bf_hi(q8.y), bf_lo(q8.z), bf_hi(q8.z), bf_lo(q8.w), bf_hi(q8.w)};
        float lv[8] = {h_lo(l8.x), h_hi(l8.x), h_lo(l8.y), h_hi(l8.y), h_lo(l8.z), h_hi(l8.z), h_lo(l8.w), h_hi(l8.w)};
        float cv[8] = {c0[0], c0[1], c0[2], c0[3], c1[0], c1[1], c1[2], c1[3]};
        float qt[8], kt[8];
#pragma unroll
        for (int j = 0; j < 8; ++j) { qt[j] = qv[j] * __expf(cv[j]); kt[j] = (1.0f - __expf(lv[j])) * __expf(-cv[j]); }
        u32x4 wq, wk;
        wq.x = cvt_pk_bf16(qt[0], qt[1]); wq.y = cvt_pk_bf16(qt[2], qt[3]); wq.z = cvt_pk_bf16(qt[4], qt[5]); wq.w = cvt_pk_bf16(qt[6], qt[7]);
        wk.x = cvt_pk_bf16(kt[0], kt[1]); wk.y = cvt_pk_bf16(kt[2], kt[3]); wk.z = cvt_pk_bf16(kt[4], kt[5]); wk.w = cvt_pk_bf16(kt[6], kt[7]);
        *(LAS u32x4*)(qs + t * 136 + e8) = wq; *(LAS u32x4*)(ks_ + t * 136 + e8) = wk; }
    __syncthreads();
    { const int tt = w >> 1;
#pragma unroll
      for (int ts2 = 0; ts2 < 2; ++ts2) { const int ts = 2 * (w & 1) + ts2; f32x4 acc = {0.f, 0.f, 0.f, 0.f};
#pragma unroll
          for (int kk = 0; kk < 4; ++kk) { const bf16x8 xf = ldfrag(ks_, 16 * ts + (lane & 15), 136, kk * 32 + (lane >> 4) * 8), yf = ldfrag(qs, 16 * tt + (lane & 15), 136, kk * 32 + (lane >> 4) * 8);
              acc = __builtin_amdgcn_mfma_f32_16x16x32_bf16(xf, yf, acc, 0, 0, 0); }
          const int t = 16 * tt + (lane & 15), s0 = 16 * ts + (lane >> 4) * 4;
          float a0 = (s0 + 0 <= t) ? acc[0] : 0.f, a1 = (s0 + 1 <= t) ? acc[1] : 0.f, a2 = (s0 + 2 <= t) ? acc[2] : 0.f, a3 = (s0 + 3 <= t) ? acc[3] : 0.f;
          u32x2 o; o.x = cvt_pk_bf16(a0, a1); o.y = cvt_pk_bf16(a2, a3); *(LAS u32x2*)(at + t * 72 + s0) = o; } }
    __syncthreads();
    { bf16x8 xi[2], xs[4];
#pragma unroll
      for (int kk = 0; kk < 2; ++kk) xi[kk] = ldfrag(iT, 16 * w + (lane & 15), 72, kk * 32 + (lane >> 4) * 8);
#pragma unroll
      for (int kk = 0; kk < 4; ++kk) xs[kk] = ldfrag(ST, 16 * w + (lane & 15), 136, kk * 32 + (lane >> 4) * 8);
#pragma unroll
      for (int tt = 0; tt < 4; ++tt) { f32x4 acc = {0.f, 0.f, 0.f, 0.f};
#pragma unroll
          for (int kk = 0; kk < 2; ++kk) { const bf16x8 yf = ldfrag(at, 16 * tt + (lane & 15), 72, kk * 32 + (lane >> 4) * 8); acc = __builtin_amdgcn_mfma_f32_16x16x32_bf16(xi[kk], yf, acc, 0, 0, 0); }
#pragma unroll
          for (int kk = 0; kk < 4; ++kk) { const bf16x8 yf = ldfrag(qs, 16 * tt + (lane & 15), 136, kk * 32 + (lane >> 4) * 8); acc = __builtin_amdgcn_mfma_f32_16x16x32_bf16(xs[kk], yf, acc, 0, 0, 0); }
          *(LAS f32x4*)(Cb + (16 * tt + (lane & 15)) * 132 + 16 * w + (lane >> 4) * 4) = acc; } }
    __syncthreads();
    { const int t = tid >> 3, v16 = (tid & 7) * 16; float ov[16]; float ss = 0.f;
#pragma unroll
      for (int k = 0; k < 4; ++k) { const f32x4 x = *(const LAS f32x4*)(Cb + t * 132 + v16 + 4 * k); ov[4 * k] = x[0]; ov[4 * k + 1] = x[1]; ov[4 * k + 2] = x[2]; ov[4 * k + 3] = x[3]; ss += (x[0] * x[0] + x[1] * x[1]) + (x[2] * x[2] + x[3] * x[3]); }
      { const int l_ = lane_id(); ss += shfl_xor_l(ss, 1, l_); ss += shfl_xor_l(ss, 2, l_); ss += shfl_xor_l(ss, 4, l_); }
      const float rstd = rsqrtf(ss * (1.0f / 128.0f) + RMS_EPS);
      const size_t off = (r0 + t) * 1024 + h * 128 + v16;
      const float gg[16] = {bf_lo(g0.x), bf_hi(g0.x), bf_lo(g0.y), bf_hi(g0.y), bf_lo(g0.z), bf_hi(g0.z), bf_lo(g0.w), bf_hi(g0.w), bf_lo(g1.x), bf_hi(g1.x), bf_lo(g1.y), bf_hi(g1.y), bf_lo(g1.z), bf_hi(g1.z), bf_lo(g1.w), bf_hi(g1.w)};
      float y[16];
#pragma unroll
      for (int k = 0; k < 4; ++k) { const f32x4 gn = *(const f32x4*)(gnorm + h * 128 + v16 + 4 * k);
#pragma unroll
          for (int j = 0; j < 4; ++j) y[4 * k + j] = ov[4 * k + j] * rstd * gn[j] * gg[4 * k + j]; }
      u32x4 o0, o1;
      o0.x = cvt_pk_bf16(y[0], y[1]); o0.y = cvt_pk_bf16(y[2], y[3]); o0.z = cvt_pk_bf16(y[4], y[5]); o0.w = cvt_pk_bf16(y[6], y[7]);
      o1.x = cvt_pk_bf16(y[8], y[9]); o1.y = cvt_pk_bf16(y[10], y[11]); o1.z = cvt_pk_bf16(y[12], y[13]); o1.w = cvt_pk_bf16(y[14], y[15]);
      *(u32x4*)(Q + off) = o0; *(u32x4*)(Q + off + 8) = o1; }
    __syncthreads();
}

__device__ __forceinline__ void sgu_item(LAS unsigned char* lds, bf16_t* UU, const bf16_t* V, const float* w_s, const float* b_s, const float* gv, const float* bv, int nb, const int wv) {
    int tid_ = wv * 64 + lane_id(); asm volatile("" : "+v"(tid_)); const int tid = tid_, lane = tid & 63, w = tid >> 6;
    const size_t r0 = (size_t)nb * 128;
    LAS bf16_t* vnT = (LAS bf16_t*)lds;
    LAS bf16_t* Wl = (LAS bf16_t*)(lds + 34816);
    LAS float* stats = (LAS float*)(lds + 69632);
    for (int rr = 0; rr < 16; ++rr) { const int row = 16 * w + rr; const bf16_t* vp = V + (r0 + row) * 1024 + lane * 16;
        const u32x4 a = *(const u32x4*)vp, b = *(const u32x4*)(vp + 8);
        float x[16] = {bf_lo(a.x), bf_hi(a.x), bf_lo(a.y), bf_hi(a.y), bf_lo(a.z), bf_hi(a.z), bf_lo(a.w), bf_hi(a.w), bf_lo(b.x), bf_hi(b.x), bf_lo(b.y), bf_hi(b.y), bf_lo(b.z), bf_hi(b.z), bf_lo(b.w), bf_hi(b.w)};
        float s = 0.f;
#pragma unroll
        for (int j = 0; j < 16; ++j) s += x[j];
        const float mean = wave_sum(s) * (1.0f / 1024.0f); float q = 0.f;
#pragma unroll
        for (int j = 0; j < 16; ++j) { const float d = x[j] - mean; q += d * d; }
        const float rstd = rsqrtf(wave_sum(q) * (1.0f / 1024.0f) + LN_EPS);
        if (lane == 0) { stats[row * 2] = mean; stats[row * 2 + 1] = rstd; } }
    __syncthreads();
    for (int g = 0; g < 8; ++g) {
        { const int c = tid & 127, part = tid >> 7; const float gam = gv[g * 128 + c], bet = bv[g * 128 + c];
#pragma unroll
          for (int k = 0; k < 4; ++k) { float vn[8];
#pragma unroll
              for (int j = 0; j < 8; ++j) { const int s = 32 * part + 8 * k + j; const float x = bf2f(V[(r0 + s) * 1024 + g * 128 + c]); vn[j] = (x - stats[s * 2]) * stats[s * 2 + 1] * gam + bet; }
              u32x4 o; o.x = cvt_pk_bf16(vn[0], vn[1]); o.y = cvt_pk_bf16(vn[2], vn[3]); o.z = cvt_pk_bf16(vn[4], vn[5]); o.w = cvt_pk_bf16(vn[6], vn[7]);
              *(LAS u32x4*)(vnT + c * 136 + 32 * part + 8 * k) = o; } }
#pragma unroll
        for (int k = 0; k < 8; ++k) { const int idx = tid + 512 * k, t = idx >> 5, s4 = (idx & 31) * 4;
            f32x4 ww = *(const f32x4*)(w_s + (size_t)g * 16384 + t * 128 + s4);
            if (t < 64 && s4 >= 64) ww = (f32x4){0.f, 0.f, 0.f, 0.f};
            u32x2 o; o.x = cvt_pk_bf16(ww[0], ww[1]); o.y = cvt_pk_bf16(ww[2], ww[3]); *(LAS u32x2*)(Wl + t * 136 + s4) = o; }
        __syncthreads();
        bf16x8 xf[4];
#pragma unroll
        for (int kk = 0; kk < 4; ++kk) xf[kk] = ldfrag(vnT, 16 * w + (lane & 15), 136, kk * 32 + (lane >> 4) * 8);
#pragma unroll
        for (int tt = 0; tt < 8; ++tt) { f32x4 acc = {0.f, 0.f, 0.f, 0.f};
#pragma unroll
            for (int kk = 0; kk < 4; ++kk) { const bf16x8 yf = ldfrag(Wl, 16 * tt + (lane & 15), 136, kk * 32 + (lane >> 4) * 8); acc = __builtin_amdgcn_mfma_f32_16x16x32_bf16(xf[kk], yf, acc, 0, 0, 0); }
            const int t = 16 * tt + (lane & 15); const float bsv = b_s[g * 128 + t];
            bf16_t* up = UU + (r0 + t) * 1024 + g * 128 + 16 * w + (lane >> 4) * 4;
            const u32x2 uu = *(const u32x2*)up;
            u32x2 o; o.x = cvt_pk_bf16(bf_lo(uu.x) * (acc[0] + bsv), bf_hi(uu.x) * (acc[1] + bsv)); o.y = cvt_pk_bf16(bf_lo(uu.y) * (acc[2] + bsv), bf_hi(uu.y) * (acc[3] + bsv));
            *(u32x2*)up = o; }
        __syncthreads();
    }
}

template <int MODE> __device__ __forceinline__ void ln_row2(float* row0, float* row1, bf16_t* xb0, bf16_t* xb1, const float* g, const float* b, int lane) {
    f32x4* xr0 = (f32x4*)row0 + lane; f32x4* xr1 = (f32x4*)row1 + lane; f32x4 v0[4], v1[4]; float s0 = 0.f, s1 = 0.f;
#pragma unroll
    for (int j = 0; j < 4; ++j) { v0[j] = xr0[64 * j]; v1[j] = xr1[64 * j]; }
#pragma unroll
    for (int j = 0; j < 4; ++j) { s0 += (v0[j][0] + v0[j][1]) + (v0[j][2] + v0[j][3]); s1 += (v1[j][0] + v1[j][1]) + (v1[j][2] + v1[j][3]); }
    const float m0 = wave_sum(s0) * (1.f / 1024.f), m1 = wave_sum(s1) * (1.f / 1024.f); float q0 = 0.f, q1 = 0.f;
#pragma unroll
    for (int j = 0; j < 4; ++j) { v0[j] = v0[j] - m0; v1[j] = v1[j] - m1; q0 += (v0[j][0] * v0[j][0] + v0[j][1] * v0[j][1]) + (v0[j][2] * v0[j][2] + v0[j][3] * v0[j][3]); q1 += (v1[j][0] * v1[j][0] + v1[j][1] * v1[j][1]) + (v1[j][2] * v1[j][2] + v1[j][3] * v1[j][3]); }
    const float r0 = rsqrtf(wave_sum(q0) * (1.f / 1024.f) + LN_EPS), r1 = rsqrtf(wave_sum(q1) * (1.f / 1024.f) + LN_EPS);
#pragma unroll
    for (int j = 0; j < 4; ++j) { const f32x4 gg = *((const f32x4*)g + lane + 64 * j), bb = *((const f32x4*)b + lane + 64 * j); const f32x4 y0 = v0[j] * r0 * gg + bb, y1 = v1[j] * r1 * gg + bb;
        if (MODE == 0) { u32x2 o; o.x = cvt_pk_bf16(y0[0], y0[1]); o.y = cvt_pk_bf16(y0[2], y0[3]); *((u32x2*)xb0 + lane + 64 * j) = o; xr0[64 * j] = y0 * ALPHA;
                         u32x2 p; p.x = cvt_pk_bf16(y1[0], y1[1]); p.y = cvt_pk_bf16(y1[2], y1[3]); *((u32x2*)xb1 + lane + 64 * j) = p; xr1[64 * j] = y1 * ALPHA; }
        else { xr0[64 * j] = y0; xr1[64 * j] = y1; } }
}

__device__ __forceinline__ void ln1_rows_bf16(const bf16_t* z0, const bf16_t* z1, bf16_t* x0, bf16_t* x1, const float* g, const float* b, int lane) {
    float v[2][16];
#pragma unroll
    for (int u = 0; u < 2; ++u) { const bf16_t* zp = (u ? z1 : z0) + lane * 16; const u32x4 a = *(const u32x4*)zp, c = *(const u32x4*)(zp + 8);
        v[u][0] = bf_lo(a.x); v[u][1] = bf_hi(a.x); v[u][2] = bf_lo(a.y); v[u][3] = bf_hi(a.y); v[u][4] = bf_lo(a.z); v[u][5] = bf_hi(a.z); v[u][6] = bf_lo(a.w); v[u][7] = bf_hi(a.w);
        v[u][8] = bf_lo(c.x); v[u][9] = bf_hi(c.x); v[u][10] = bf_lo(c.y); v[u][11] = bf_hi(c.y); v[u][12] = bf_lo(c.z); v[u][13] = bf_hi(c.z); v[u][14] = bf_lo(c.w); v[u][15] = bf_hi(c.w); }
    float gg[16], bb[16];
#pragma unroll
    for (int k = 0; k < 4; ++k) { const f32x4 g4 = *(const f32x4*)(g + lane * 16 + 4 * k), b4 = *(const f32x4*)(b + lane * 16 + 4 * k);
#pragma unroll
        for (int j = 0; j < 4; ++j) { gg[4 * k + j] = g4[j]; bb[4 * k + j] = b4[j]; } }
#pragma unroll
    for (int u = 0; u < 2; ++u) { float s = 0.f;
#pragma unroll
        for (int j = 0; j < 16; ++j) s += v[u][j];
        const float mean = wave_sum(s) * (1.f / 1024.f); float q = 0.f;
#pragma unroll
        for (int j = 0; j < 16; ++j) { v[u][j] -= mean; q += v[u][j] * v[u][j]; }
        const float rstd = rsqrtf(wave_sum(q) * (1.f / 1024.f) + LN_EPS);
        float y[16];
#pragma unroll
        for (int j = 0; j < 16; ++j) y[j] = v[u][j] * rstd * gg[j] + bb[j];
        u32x4 o0, o1;
        o0.x = cvt_pk_bf16(y[0], y[1]); o0.y = cvt_pk_bf16(y[2], y[3]); o0.z = cvt_pk_bf16(y[4], y[5]); o0.w = cvt_pk_bf16(y[6], y[7]);
        o1.x = cvt_pk_bf16(y[8], y[9]); o1.y = cvt_pk_bf16(y[10], y[11]); o1.z = cvt_pk_bf16(y[12], y[13]); o1.w = cvt_pk_bf16(y[14], y[15]);
        bf16_t* xp = (u ? x1 : x0) + lane * 16; *(u32x4*)xp = o0; *(u32x4*)(xp + 8) = o1; }
}

__device__ __forceinline__ void conv_pass(bf16_t* HH, const float* cw, const float* cb, int gt, int nthreads) {
    for (int task = gt; task < 352 * 1024; task += nthreads) {
        const int strip = task % 352, rb = task / 352, c0 = strip * 8; const size_t r0 = (size_t)rb * 32; const int t0 = (int)(r0 & (SEQ - 1));
        float w0[8], w1[8], w2[8], bb[8], gm2[8], gm1[8];
#pragma unroll
        for (int j = 0; j < 8; ++j) { w0[j] = cw[c0 + j]; w1[j] = cw[DFF + c0 + j]; w2[j] = cw[2 * DFF + c0 + j]; bb[j] = cb[c0 + j]; gm2[j] = 0.f; gm1[j] = 0.f; }
        if (t0 != 0) { const u32x4 a = *(const u32x4*)(HH + (r0 - 2) * 5632 + c0), b = *(const u32x4*)(HH + (r0 - 1) * 5632 + c0);
            gm2[0] = bf_lo(a.x); gm2[1] = bf_hi(a.x); gm2[2] = bf_lo(a.y); gm2[3] = bf_hi(a.y); gm2[4] = bf_lo(a.z); gm2[5] = bf_hi(a.z); gm2[6] = bf_lo(a.w); gm2[7] = bf_hi(a.w);
            gm1[0] = bf_lo(b.x); gm1[1] = bf_hi(b.x); gm1[2] = bf_lo(b.y); gm1[3] = bf_hi(b.y); gm1[4] = bf_lo(b.z); gm1[5] = bf_hi(b.z); gm1[6] = bf_lo(b.w); gm1[7] = bf_hi(b.w); }
#pragma unroll 8
        for (int rr = 0; rr < 32; ++rr) { bf16_t* rp = HH + (r0 + rr) * 5632 + c0;
            const u32x4 a = *(const u32x4*)rp, vv = *(const u32x4*)(rp + DFF);
            const float gc[8] = {bf_lo(a.x), bf_hi(a.x), bf_lo(a.y), bf_hi(a.y), bf_lo(a.z), bf_hi(a.z), bf_lo(a.w), bf_hi(a.w)};
            const float vl[8] = {bf_lo(vv.x), bf_hi(vv.x), bf_lo(vv.y), bf_hi(vv.y), bf_lo(vv.z), bf_hi(vv.z), bf_lo(vv.w), bf_hi(vv.w)};
            float o[8];
#pragma unroll
            for (int j = 0; j < 8; ++j) { const float y = w0[j] * gm2[j] + w1[j] * gm1[j] + w2[j] * gc[j] + bb[j]; o[j] = geluf_(y) * vl[j]; gm2[j] = gm1[j]; gm1[j] = gc[j]; }
            u32x4 ow; ow.x = cvt_pk_bf16(o[0], o[1]); ow.y = cvt_pk_bf16(o[2], o[3]); ow.z = cvt_pk_bf16(o[4], o[5]); ow.w = cvt_pk_bf16(o[6], o[7]);
            *(u32x4*)(rp + DFF) = ow; }
    }
}

struct Args { const float* in[21]; float* out; unsigned char* ws; };

typedef const Args __attribute__((address_space(4))) * ArgsP;
__device__ __forceinline__ ArgsP get_args() { ArgsP p = (ArgsP)__builtin_amdgcn_kernarg_segment_ptr(); asm volatile("" : "+s"(p)); return p; }
#define WSP(T, off) ((T*)(ap->ws + (off)))

#define XB_TMO      128
#define XB_XCNT(j)  (256  + 64 * (j))
#define XB_XSUB(j)  (1280 + 64 * (j))
#define XB_XGEN(j)  (2304 + 64 * (j))
#define XB_TOP      3328
#define XB_TOPGEN   3392
#define XCD_BAR_WORDS 3456
#define XB_SPIN_CAP (1u << 22)
__device__ __forceinline__ unsigned xb_ld(unsigned* p)              { return __hip_atomic_load(p, __ATOMIC_RELAXED, __HIP_MEMORY_SCOPE_AGENT); }
__device__ __forceinline__ unsigned xb_add(unsigned* p, unsigned v) { return __hip_atomic_fetch_add(p, v, __ATOMIC_RELAXED, __HIP_MEMORY_SCOPE_AGENT); }
__device__ __forceinline__ unsigned xb_xcc_id() { return (unsigned)__builtin_amdgcn_s_getreg((3 << 11) | 20) & 0xFu; }
#define XB_SPIN(cond, bar) do { unsigned _sp = 0; while (cond) { __builtin_amdgcn_s_sleep(1); \
    if ((++_sp & 255u) == 0u) { if (xb_ld(&(bar)[XB_TMO])) break; if (_sp > XB_SPIN_CAP) { atomicAdd(&(bar)[XB_TMO], 1u); break; } } } } while (0)
struct XcdBarrier { unsigned* bar; unsigned x; volatile LAS unsigned* st; };
__device__ __forceinline__ XcdBarrier xcd_barrier_post(unsigned* bar, volatile LAS unsigned* st) {
    XcdBarrier b; b.bar = bar; b.x = xb_xcc_id(); b.st = st;
    if (threadIdx.x == 0) (void)xb_add(&bar[XB_XCNT(b.x)], 1u);
    return b;
}
__device__ __forceinline__ void xcd_barrier_complete(unsigned* bar, unsigned x, unsigned& nloc, unsigned& nx) {
    const unsigned Gn = gridDim.x * gridDim.y * gridDim.z;
    unsigned sum, cnt, mine, sp = 0u;
    for (;;) {
        sum = 0u; cnt = 0u; mine = 0u;
#pragma unroll
        for (unsigned j = 0; j < 16; ++j) { const unsigned c = xb_ld(&bar[XB_XCNT(j)]); sum += c; cnt += (c > 0u) ? 1u : 0u; mine = (j == x) ? c : mine; }
        if (sum == Gn) break;
        __builtin_amdgcn_s_sleep(1);
        if ((++sp & 255u) == 0u) { if (xb_ld(&bar[XB_TMO])) break; if (sp > XB_SPIN_CAP) { atomicAdd(&bar[XB_TMO], 1u); break; } }
    }
    nloc = mine > 0u ? mine : 1u; nx = cnt > 0u ? cnt : 1u;
}
__device__ __forceinline__ void xcd_barrier(const XcdBarrier& b, const bool leader) {
    asm volatile("s_waitcnt vmcnt(0)" ::: "memory");
    __syncthreads();
    if (leader) {
        unsigned* bar = b.bar;
        __builtin_amdgcn_s_waitcnt(0);
        unsigned nloc = b.st[0], nx = b.st[1];
        if (nloc == 0u) { xcd_barrier_complete(bar, b.x, nloc, nx); b.st[0] = nloc; b.st[1] = nx; }
        const unsigned old = xb_add(&bar[XB_XSUB(b.x)], 1u);
        const unsigned gen = old / nloc;
        if (old + 1u == (gen + 1u) * nloc) {
            __builtin_amdgcn_fence(__ATOMIC_RELEASE, "agent");
            asm volatile("s_waitcnt vmcnt(0)" ::: "memory");
            const unsigned og = xb_add(&bar[XB_TOP], 1u);
            const unsigned tg = og / nx;
            if (og + 1u == (tg + 1u) * nx) xb_add(&bar[XB_TOPGEN], 1u);
            else XB_SPIN(xb_ld(&bar[XB_TOPGEN]) == tg, bar);
            __builtin_amdgcn_fence(__ATOMIC_ACQUIRE, "agent");
            xb_add(&bar[XB_XGEN(b.x)], 1u);
            asm volatile("s_waitcnt vmcnt(0)" ::: "memory");
        } else {
            XB_SPIN(xb_ld(&bar[XB_XGEN(b.x)]) == gen, bar);
            __builtin_amdgcn_fence(__ATOMIC_ACQUIRE, "agent");
            asm volatile("s_waitcnt vmcnt(0)" ::: "memory");
        }
    }
    __syncthreads();
}
#define SYNC() do { XcdBarrier xb_; xb_.bar = (unsigned*)get_args()->ws; xb_.x = xb_xcc_id(); xb_.st = (volatile LAS unsigned*)(lds + LDS_BYTES - 16); xcd_barrier(xb_, wv == 0 && lane_id() == 0); } while (0)
__global__ void __launch_bounds__(512, 2) fwd_kernel(Args a_unused) {
    extern __shared__ __attribute__((aligned(16))) unsigned char lds_raw[];
    LAS unsigned char* lds = (LAS unsigned char*)lds_raw;
    if (gridDim.x == 0x7fffffffu) cg::this_grid().sync();
    if (threadIdx.x < 4) ((volatile LAS unsigned*)(lds + LDS_BYTES - 16))[threadIdx.x] = 0u;
    __syncthreads();
    (void)xcd_barrier_post((unsigned*)get_args()->ws, (volatile LAS unsigned*)(lds + LDS_BYTES - 16));
    const int wv = __builtin_amdgcn_readfirstlane((int)threadIdx.x >> 6);
#define lane (lane_id())
#define gt ((int)(blockIdx.x * 512 + wv * 64 + lane_id()))
#define wave (wv)
#define G ((int)gridDim.x)
#define bx ((int)blockIdx.x)
#define nthreads (G * 512)
#define gw (bx * 8 + wave)
#define NGW (G * 8)

    {
        ArgsP ap = get_args();
        const float* w_in = ap->in[2]; const float* w_branch = ap->in[9]; const float* w_out = ap->in[10]; const float* w_up = ap->in[13]; const float* w_down = ap->in[16]; const float* w_pp = ap->in[19]; const float* w_pg = ap->in[20];
        LAS float* scr = (LAS float*)(lds + wave * 16384);
        constexpr int I_IN = 16 * 256, I_SQ = 16 * 32, I_UP = 16 * 176, I_DN = 44 * 32, I_PP = 4 * 32;
        constexpr int NITEMS = I_IN + 4 * I_SQ + I_UP + I_DN + I_PP;
        for (int it = gw; it < NITEMS; it += NGW) {
            int r = it;
            if (r < I_IN) { const int nb = r % 256, sec = nb >> 5;
                const int nsec = sec == 0 ? 4 : sec == 1 ? 5 : sec == 2 ? 0 : sec == 3 ? 1 : sec == 4 ? 2 : sec == 5 ? 3 : sec;
                p0_transpose_item(w_in, 1024, 8192, WSP(bf16_t, WS_WIN), (nsec - sec) * 1024, scr, r, lane); continue; } r -= I_IN;
            if (r < I_SQ) { p0_transpose_item(w_branch, 1024, 1024, WSP(bf16_t, WS_WA), 0, scr, r, lane); continue; } r -= I_SQ;
            if (r < I_SQ) { p0_transpose_item(w_branch + 1024 * 1024, 1024, 1024, WSP(bf16_t, WS_WB), 0, scr, r, lane); continue; } r -= I_SQ;
            if (r < I_SQ) { p0_transpose_item(w_out, 1024, 1024, WSP(bf16_t, WS_WOUT), 0, scr, r, lane); continue; } r -= I_SQ;
            if (r < I_SQ) { p0_transpose_item(w_pg, 1024, 1024, WSP(bf16_t, WS_WPG), 0, scr, r, lane); continue; } r -= I_SQ;
            if (r < I_UP) { p0_transpose_item(w_up, 1024, 5632, WSP(bf16_t, WS_WUP), 0, scr, r, lane); continue; } r -= I_UP;
            if (r < I_DN) { p0_transpose_item(w_down, 2816, 1024, WSP(bf16_t, WS_WDN), 0, scr, r, lane); continue; } r -= I_DN;
            p0_transpose_item(w_pp, 256, 1024, WSP(bf16_t, WS_WPP), 0, scr, r, lane);
        }
        cvt_f32_bf16(ap->in[0], WSP(bf16_t, WS_XBF), (size_t)M * D / 8, (size_t)gt, (size_t)nthreads);
        cvt_f32_bf16(ap->in[1], WSP(bf16_t, WS_PBF), (size_t)M * PLE / 8, (size_t)gt, (size_t)nthreads);
        if (gt < 1024) { const float* lbl = ap->in[7]; WSP(float, WS_LB)[gt] = sigmoidf_(lbl[gt] - lbl[1024 + gt]); }
    }
    SYNC();

    {
        ArgsP ap = get_args();
        pg8::Gemm g{WSP(bf16_t, WS_XBF), WSP(bf16_t, WS_WIN), M, 4096, 1024, 1024}; pg8::StaticOrder S; S.init(M, 4096, G, bx);
        pg8::EpiSec E{WSP(bf16_t, WS_Q), (size_t)32 * MiB, pg8::ACT_SILU | (pg8::ACT_LOGF << 4) | (pg8::ACT_NONE << 8) | (pg8::ACT_SILU << 12), 1024, 1024, WSP(float, WS_LB)};
        pg8::gemm_phase<pg8::EpiSec>(lds, g, S, E, wv);
    }
    SYNC();

    { ArgsP ap = get_args();
      for (int item = bx; item < 4096; item += 2 * G) { const int itemB = item + G < 4096 ? item + G : item;
        hgrn_pass_b2(lds, WSP(_Float16, WS_LOGF), WSP(bf16_t, WS_I), WSP(bf16_t, WS_U), WSP(float, WS_DTAB), item, itemB, wv); } }
    SYNC();
    { ArgsP ap = get_args(); hgrn_scan(WSP(bf16_t, WS_U), WSP(float, WS_DTAB), gt, nthreads); }
    SYNC();
    { ArgsP ap = get_args();
      for (int item = bx; item < 4096; item += G) hgrn_pass_ad(lds, WSP(bf16_t, WS_Q), WSP(_Float16, WS_LOGF), WSP(bf16_t, WS_I), WSP(bf16_t, WS_OG), WSP(bf16_t, WS_U), ap->in[8], item, wv); }
    SYNC();

    {
        ArgsP ap = get_args();
        pg8::Gemm g{WSP(bf16_t, WS_XBF), WSP(bf16_t, WS_WIN + 8 * MiB), M, 4096, 1024, 1024}; pg8::StaticOrder S; S.init(M, 4096, G, bx);
        pg8::EpiSec E{WSP(bf16_t, WS_LOGF), (size_t)32 * MiB, pg8::ACT_GELU | (pg8::ACT_GELU << 4) | (pg8::ACT_SIGM << 8) | (pg8::ACT_SIGM << 12), 1024, 1024, WSP(float, WS_LB)};
        pg8::gemm_phase<pg8::EpiSec>(lds, g, S, E, wv);
    }
    SYNC();

    { ArgsP ap = get_args();
      for (int nb = bx; nb < 256; nb += G) sgu_item(lds, WSP(bf16_t, WS_LOGF), WSP(bf16_t, WS_I), ap->in[3], ap->in[4], ap->in[5], ap->in[6], nb, wv); }
    SYNC();

    {
        ArgsP ap = get_args();
        pg8::StaticOrder S; S.init(M, 1024, G, bx);
        bf16_t* Tb = (bf16_t*)ap->out;
        { pg8::Gemm g{WSP(bf16_t, WS_LOGF), WSP(bf16_t, WS_WA), M, 1024, 1024, 1024}; pg8::EpiF32<pg8::MODE_T> E{nullptr, nullptr, WSP(bf16_t, WS_OG), nullptr, 0, Tb, 1024}; pg8::gemm_phase<pg8::EpiF32<pg8::MODE_T>>(lds, g, S, E, wv); }
        { pg8::Gemm g{WSP(bf16_t, WS_Q), WSP(bf16_t, WS_WB), M, 1024, 1024, 1024}; pg8::EpiF32<pg8::MODE_M> E{nullptr, nullptr, WSP(bf16_t, WS_U), Tb, 1024, WSP(bf16_t, WS_XBF), 1024}; pg8::gemm_phase<pg8::EpiF32<pg8::MODE_M>>(lds, g, S, E, wv); }
    }
    SYNC();

    {
        ArgsP ap = get_args();
        pg8::StaticOrder S; S.init(M, 1024, G, bx);
        pg8::Gemm g{WSP(bf16_t, WS_XBF), WSP(bf16_t, WS_WOUT), M, 1024, 1024, 1024}; pg8::EpiF32<pg8::MODE_Z> E{nullptr, ap->in[0], nullptr, nullptr, 0, (bf16_t*)ap->out, 1024}; pg8::gemm_phase<pg8::EpiF32<pg8::MODE_Z>>(lds, g, S, E, wv);
    }
    SYNC();

    { ArgsP ap = get_args(); const bf16_t* Zb = (const bf16_t*)ap->out; bf16_t* X1 = WSP(bf16_t, WS_XBF); const float* g1 = ap->in[11]; const float* b1 = ap->in[12];
      for (int m = 2 * gw; m < M; m += 2 * NGW) ln1_rows_bf16(Zb + (size_t)m * 1024, Zb + (size_t)(m + 1) * 1024, X1 + (size_t)m * 1024, X1 + (size_t)(m + 1) * 1024, g1, b1, lane); }
    SYNC();

    {
        ArgsP ap = get_args();
        pg8::Gemm g{WSP(bf16_t, WS_XBF), WSP(bf16_t, WS_WUP), M, 5632, 1024, 1024}; pg8::StaticOrder S; S.init(M, 5632, G, bx);
        pg8::EpiSec E{WSP(bf16_t, WS_HH), 0, 0, 5632, 8192, WSP(float, WS_LB)};
        pg8::gemm_phase<pg8::EpiSec>(lds, g, S, E, wv);
    }
    SYNC();

    { ArgsP ap = get_args(); conv_pass(WSP(bf16_t, WS_HH), ap->in[14], ap->in[15], gt, nthreads); }
    SYNC();

    {
        ArgsP ap = get_args();
        pg8::StaticOrder S; S.init(M, 1024, G, bx);
        bf16_t* E1 = WSP(bf16_t, WS_HH);
        { pg8::Gemm g{WSP(bf16_t, WS_PBF), WSP(bf16_t, WS_WPP), M, 1024, 256, 256}; pg8::EpiF32<pg8::MODE_E> E{nullptr, nullptr, nullptr, nullptr, 0, E1, 5632}; pg8::gemm_phase<pg8::EpiF32<pg8::MODE_E>>(lds, g, S, E, wv); }
        { pg8::Gemm g{WSP(bf16_t, WS_XBF), WSP(bf16_t, WS_WPG), M, 1024, 1024, 1024}; pg8::EpiF32<pg8::MODE_PLE> E{nullptr, nullptr, nullptr, E1, 5632, E1, 5632}; pg8::gemm_phase<pg8::EpiF32<pg8::MODE_PLE>>(lds, g, S, E, wv); }
        { pg8::Gemm g{WSP(bf16_t, WS_HH) + DFF, WSP(bf16_t, WS_WDN), M, 1024, 2816, 5632}; pg8::EpiF32<pg8::MODE_FIN> E{ap->out, nullptr, WSP(bf16_t, WS_XBF), E1, 5632, nullptr, 0}; pg8::gemm_phase<pg8::EpiF32<pg8::MODE_FIN>>(lds, g, S, E, wv); }
    }
    SYNC();

    { ArgsP ap = get_args(); float* OUT = ap->out; const float* g2 = ap->in[17]; const float* b2 = ap->in[18];
      for (int m = 2 * gw; m < M; m += 2 * NGW) ln_row2<1>(OUT + (size_t)m * 1024, OUT + (size_t)(m + 1) * 1024, nullptr, nullptr, g2, b2, lane); }
}
#undef wave
#undef G
#undef bx
#undef nthreads
#undef gw
#undef NGW
#undef lane
#undef gt
extern "C" void kernel_launch(void* const* d_in, const int* in_sizes, int n_in, void* d_out, int out_size, void* d_ws, size_t ws_size, hipStream_t stream) {
    static int grid = 0;
    if (grid == 0) {
        if (n_in != 21 || out_size != M * D || ws_size < WS_NEED) { fprintf(stderr, "kernel_launch: unexpected shapes (n_in %d out %d ws %zu)\n", n_in, out_size, ws_size); grid = -1; return; }
        int dev = 0, cus = 0, per_cu = 0;
        hipGetDevice(&dev);
        hipDeviceGetAttribute(&cus, hipDeviceAttributeMultiprocessorCount, dev);
        hipFuncSetAttribute((const void*)fwd_kernel, hipFuncAttributeMaxDynamicSharedMemorySize, LDS_BYTES);
        hipOccupancyMaxActiveBlocksPerMultiprocessor(&per_cu, (const void*)fwd_kernel, 512, LDS_BYTES);
        if (per_cu < 1) per_cu = 1;
        grid = cus * per_cu;
        (void)hipGetLastError();
    }
    if (grid < 0) return;
    if (hipMemsetAsync(d_ws, 0, 16384, stream) != hipSuccess) { fprintf(stderr, "memset failed\n"); return; }
    Args a{};
    for (int i = 0; i < 21; ++i) a.in[i] = (const float*)d_in[i];
    a.out = (float*)d_out; a.ws = (unsigned char*)d_ws;
    void* args[] = {&a};
    hipError_t e = hipLaunchCooperativeKernel((const void*)fwd_kernel, dim3(grid), dim3(512), args, LDS_BYTES, stream);
    if (e != hipSuccess) fprintf(stderr, "cooperative launch failed: %s (grid %d)\n", hipGetErrorString(e), grid);
}
```

```cpp
#include <hip/hip_runtime.h>
#include <hip/hip_cooperative_groups.h>
#include <cstdio>
#include <cstdint>
namespace cg = cooperative_groups;

#define LAS __attribute__((address_space(3)))
typedef unsigned short bf16_t;
typedef short bf16x8 __attribute__((ext_vector_type(8)));
typedef float f32x4 __attribute__((ext_vector_type(4)));
typedef float f32x2 __attribute__((ext_vector_type(2)));
typedef unsigned u32x4 __attribute__((ext_vector_type(4)));
typedef unsigned u32x2 __attribute__((ext_vector_type(2)));

constexpr int M = 32768, D = 1024, SEQ = 4096, DFF = 2816, PLE = 256;
constexpr float LN_EPS = 1e-5f, RMS_EPS = 1e-6f;
constexpr float ALPHA = 1.189207115002721f;
constexpr int LDS_BYTES = 147456;

constexpr size_t MiB = 1u << 20;
constexpr size_t WS_LB = MiB / 2;
constexpr size_t WS_WIN = 1 * MiB, WS_WA = 17 * MiB, WS_WB = 19 * MiB, WS_WOUT = 21 * MiB, WS_WUP = 23 * MiB, WS_WDN = 34 * MiB, WS_WPG = 40 * MiB, WS_WPP = 42 * MiB;
constexpr size_t WS_DTAB = 43 * MiB;
constexpr size_t WS_XBF = 48 * MiB;
constexpr size_t WS_Q = 112 * MiB;
constexpr size_t WS_LOGF = 176 * MiB;
constexpr size_t WS_I = 240 * MiB;
constexpr size_t WS_OG = 304 * MiB;
constexpr size_t WS_U = 368 * MiB;
constexpr size_t WS_ACT = 112 * MiB;
constexpr size_t WS_E1 = 288 * MiB;
constexpr size_t WS_GL = 464 * MiB, WS_GF = 468 * MiB, WS_VF = 472 * MiB;
constexpr size_t WS_PBF = 496 * MiB;
constexpr size_t WS_NEED = 512 * MiB;

typedef __bf16 bf16x2_t __attribute__((ext_vector_type(2)));
__device__ __forceinline__ unsigned cvt_pk_bf16(float lo, float hi) { const f32x2 v = {lo, hi}; const bf16x2_t b = __builtin_convertvector(v, bf16x2_t); return __builtin_bit_cast(unsigned, b); }
__device__ __forceinline__ float bf_lo(unsigned w) { return __uint_as_float(w << 16); }
__device__ __forceinline__ float bf_hi(unsigned w) { return __uint_as_float(w & 0xffff0000u); }
__device__ __forceinline__ float bf2f(bf16_t h) { return __uint_as_float((unsigned)h << 16); }
__device__ __forceinline__ unsigned pk_f16(float lo, float hi) { const _Float16 a = (_Float16)lo, b = (_Float16)hi; return (unsigned)__builtin_bit_cast(unsigned short, a) | ((unsigned)__builtin_bit_cast(unsigned short, b) << 16); }
__device__ __forceinline__ float h_lo(unsigned w) { return (float)__builtin_bit_cast(_Float16, (unsigned short)(w & 0xffffu)); }
__device__ __forceinline__ float h_hi(unsigned w) { return (float)__builtin_bit_cast(_Float16, (unsigned short)(w >> 16)); }
__device__ __forceinline__ float sigmoidf_(float x) { return __builtin_amdgcn_rcpf(1.0f + __expf(-x)); }
__device__ __forceinline__ float siluf_(float x) { return x * sigmoidf_(x); }
__device__ __forceinline__ float geluf_(float x) { return x * sigmoidf_(1.5957691216057308f * (x + 0.044715f * x * x * x)); }
__device__ __forceinline__ int lane_id() { int l = (int)__builtin_amdgcn_mbcnt_hi(~0u, __builtin_amdgcn_mbcnt_lo(~0u, 0u)); asm volatile("" : "+v"(l)); return l; }
__device__ __forceinline__ float shfl_xor_l(float v, int o, int l) { return __int_as_float(__builtin_amdgcn_ds_bpermute((l ^ o) << 2, __float_as_int(v))); }
__device__ __forceinline__ float wave_sum(float v) {
    const int l = lane_id();
#pragma unroll
    for (int o = 1; o < 64; o <<= 1) v += shfl_xor_l(v, o, l);
    return v;
}

namespace pg8 {
constexpr int BM = 256, BK = 64, HALF = 128, HTB = HALF * BK * 2, STAGE_BYTES = 8 * HTB, NXCD = 8, WGM = 8;
__host__ __device__ __forceinline__ int lds_byte(int r, int c) { const int st = (r >> 4) * 2 + (c >> 5), rr = r & 15, cc = c & 31, ob = rr * 64 + cc * 2; return st * 1024 + (ob ^ (((ob >> 9) & 1) << 5)); }
__host__ __device__ __forceinline__ void stage_rc(int b, int& R, int& C) { const int st = b / 1024, sb = b % 1024, swz = sb ^ (((sb >> 9) & 1) << 5); R = (st >> 1) * 16 + swz / 64; C = (st & 1) * 32 + (swz % 64) / 2; }
__host__ __device__ __forceinline__ int perm32(int rho) { const int n = rho >> 4, i = rho & 15; return 8 * (i >> 2) + 4 * n + (i & 3); }

struct Unit { int pm, pn; };
struct Gemm { const bf16_t* A; const bf16_t* Bt; int M, N, K, lda; };

struct StaticOrder {
    int nM, nN, nwg, G, c;
    __device__ void init(int M_, int N_, int G_, int c_) { nM = M_ / BM; nN = N_ / BM; nwg = nM * nN; G = G_; c = c_; }
    __device__ bool next(int i, Unit& u) const {
        const long L = (long)i * G + c; if (L >= nwg) return false;
        int wgid = (int)L; { const int q = nwg / NXCD, r = nwg % NXCD, xcd = wgid % NXCD, off = wgid / NXCD; wgid = (xcd < r ? xcd * (q + 1) : r * (q + 1) + (xcd - r) * q) + off; }
        const int nig = WGM * nN, gid = wgid / nig, fm = gid * WGM, gsz = (nM - fm) < WGM ? (nM - fm) : WGM;
        u.pm = fm + ((wgid % nig) % gsz); u.pn = (wgid % nig) / gsz; return true;
    }
};

template <class Epi>
__device__ __forceinline__ void gemm_phase(LAS unsigned char* lds, const Gemm g, const StaticOrder& S, const Epi& E, const int wv) {
    int tid_ = wv * 64 + lane_id(); asm volatile("" : "+v"(tid_));
    const int tid = tid_, wid = __builtin_amdgcn_readfirstlane(tid >> 6), lane = tid & 63, wr = wid >> 2, wc = wid & 3, fr = lane & 15, fq = lane >> 4;
    const int K = g.K, nt = K / BK, lda = g.lda;
    unsigned voffA[2], voffB[2];
#pragma unroll
    for (int i = 0; i < 2; ++i) { int R, C; stage_rc(tid * 16 + i * 8192, R, C); const int Rb = Epi::PERM ? ((R & ~31) + perm32(R & 31)) : R;
        voffA[i] = (unsigned)(R * lda + C) * 2u; voffB[i] = (unsigned)(Rb * K + C) * 2u; }
    const size_t kstep = (size_t)(BK * 2);
    const size_t hstepA = (size_t)HALF * lda * 2, hstepB = (size_t)HALF * K * 2;
    const size_t tstepA = 2 * hstepA, tstepB = 2 * hstepB;
    const unsigned ldsw = (unsigned)wid * 1024u;
    const int aoff = lds_byte(wr * 64 + fr, fq * 8), boff = lds_byte(wc * 32 + fr, fq * 8);
#define PG8_SA(b, h) (((b) * 2 + (h)) * HTB)
#define PG8_SB(b, h) ((4 + (b) * 2 + (h)) * HTB)
#define PG8_STAGE(bufoff, gbase, voff) do { _Pragma("unroll") for (int _i = 0; _i < 2; ++_i) \
        __builtin_amdgcn_global_load_lds((const unsigned*)((const char*)(gbase) + (voff)[_i]), (LAS unsigned*)(lds + (bufoff) + ldsw + _i * 8192), 16, 0, 0); } while (0)
#define PG8_LDA(dst, b, h) do { _Pragma("unroll") for (int m = 0; m < 4; ++m) _Pragma("unroll") for (int k = 0; k < 2; ++k) dst[m][k] = *(const LAS bf16x8*)(lds + PG8_SA(b, h) + aoff + m * 2048 + k * 1024); } while (0)
#define PG8_LDB(dst, b, h) do { _Pragma("unroll") for (int n = 0; n < 2; ++n) _Pragma("unroll") for (int k = 0; k < 2; ++k) dst[n][k] = *(const LAS bf16x8*)(lds + PG8_SB(b, h) + boff + n * 2048 + k * 1024); } while (0)
#define PG8_MMA(ai, bj, At, Bt) do { __builtin_amdgcn_s_setprio(1); _Pragma("unroll") for (int m = 0; m < 4; ++m) _Pragma("unroll") for (int n = 0; n < 2; ++n) _Pragma("unroll") for (int k = 0; k < 2; ++k) \
        acc[ai][bj][m][n] = __builtin_amdgcn_mfma_f32_16x16x32_bf16(Bt[n][k], At[m][k], acc[ai][bj][m][n], 0, 0, 0); __builtin_amdgcn_s_setprio(0); } while (0)
#define PG8_WAIT_V(n) asm volatile("s_waitcnt vmcnt(" #n ")" ::: "memory")
#define PG8_WAIT_L(n) asm volatile("s_waitcnt lgkmcnt(" #n ")" ::: "memory")
#define PG8_BAR __builtin_amdgcn_s_barrier()
#define PG8_SCHED __builtin_amdgcn_sched_barrier(0)
    Unit cur, nxt; int ui = 0;
    if (!S.next(0, cur)) return;
    f32x4 acc[2][2][4][2];
#pragma unroll
    for (int a = 0; a < 2; ++a)
#pragma unroll
        for (int b = 0; b < 2; ++b)
#pragma unroll
            for (int m = 0; m < 4; ++m)
#pragma unroll
                for (int n = 0; n < 2; ++n) acc[a][b][m][n] = (f32x4){0.f, 0.f, 0.f, 0.f};
    bf16x8 At[4][2], B0[2][2], B1[2][2];
    const char* cA = (const char*)g.A + (size_t)cur.pm * tstepA; const char* cB = (const char*)g.Bt + (size_t)cur.pn * tstepB;
    PG8_STAGE(PG8_SB(0, 0), cB, voffB); PG8_STAGE(PG8_SB(0, 1), cB + hstepB, voffB); PG8_STAGE(PG8_SA(0, 0), cA, voffA); PG8_STAGE(PG8_SA(0, 1), cA + hstepA, voffA);
    if (wr == 1) PG8_BAR;
    PG8_WAIT_V(2); PG8_BAR;
    PG8_STAGE(PG8_SB(1, 0), cB + kstep, voffB); PG8_STAGE(PG8_SA(1, 0), cA + kstep, voffA); PG8_STAGE(PG8_SB(1, 1), cB + hstepB + kstep, voffB);
    PG8_WAIT_V(6); PG8_BAR;
    for (;;) {
        const bool has_next = S.next(ui + 1, nxt);
        const char* nA = has_next ? (const char*)g.A + (size_t)nxt.pm * tstepA : cA; const char* nB = has_next ? (const char*)g.Bt + (size_t)nxt.pn * tstepB : cB;
        for (int t = 0; t < nt; t += 2) {
            const bool last = (t == nt - 2);
            const char* a1 = cA + (size_t)(t + 1) * kstep;
            const char* a2 = last ? nA : cA + (size_t)(t + 2) * kstep; const char* b2 = last ? nB : cB + (size_t)(t + 2) * kstep;
            const char* a3 = a2 + kstep; const char* b3 = b2 + kstep;
            PG8_LDB(B0, 0, 0); PG8_LDB(B1, 0, 1); PG8_SCHED; PG8_LDA(At, 0, 0); PG8_STAGE(PG8_SA(1, 1), a1 + hstepA, voffA);
            PG8_WAIT_V(8); PG8_WAIT_L(0); PG8_BAR; PG8_MMA(0, 0, At, B0); PG8_MMA(0, 1, At, B1); PG8_BAR; PG8_SCHED;
            PG8_LDA(At, 0, 1); PG8_STAGE(PG8_SB(0, 0), b2, voffB); PG8_STAGE(PG8_SB(0, 1), b2 + hstepB, voffB); PG8_STAGE(PG8_SA(0, 0), a2, voffA);
            PG8_WAIT_V(8); PG8_WAIT_L(0); PG8_BAR; PG8_MMA(1, 0, At, B0); PG8_MMA(1, 1, At, B1); PG8_BAR; PG8_SCHED;
            PG8_LDB(B0, 1, 0); PG8_LDB(B1, 1, 1); PG8_SCHED; PG8_LDA(At, 1, 0); PG8_STAGE(PG8_SA(0, 1), a2 + hstepA, voffA);
            PG8_WAIT_V(8); PG8_WAIT_L(0); PG8_BAR; PG8_MMA(0, 0, At, B0); PG8_MMA(0, 1, At, B1); PG8_BAR; PG8_SCHED;
            PG8_LDA(At, 1, 1); PG8_STAGE(PG8_SB(1, 0), b3, voffB); PG8_STAGE(PG8_SB(1, 1), b3 + hstepB, voffB); PG8_STAGE(PG8_SA(1, 0), a3, voffA);
            PG8_WAIT_V(8); PG8_WAIT_L(0); PG8_BAR; PG8_MMA(1, 0, At, B0); PG8_MMA(1, 1, At, B1); PG8_BAR; PG8_SCHED;
        }
        if (wr == 0) PG8_BAR;
        E(acc, cur, wr, wc, fr, fq);
        if (!has_next) break;
#pragma unroll
        for (int a = 0; a < 2; ++a)
#pragma unroll
            for (int b = 0; b < 2; ++b)
#pragma unroll
                for (int m = 0; m < 4; ++m)
#pragma unroll
                    for (int n = 0; n < 2; ++n) acc[a][b][m][n] = (f32x4){0.f, 0.f, 0.f, 0.f};
        cur = nxt; cA = nA; cB = nB; ++ui;
        if (wr == 1) PG8_BAR;
    }
    PG8_WAIT_V(0);
    PG8_BAR;
#undef PG8_SA
#undef PG8_SB
#undef PG8_STAGE
#undef PG8_LDA
#undef PG8_LDB
#undef PG8_MMA
#undef PG8_WAIT_V
#undef PG8_WAIT_L
#undef PG8_BAR
#undef PG8_SCHED
}

enum { ACT_NONE = 0, ACT_GELU = 1, ACT_SILU = 2, ACT_SIGM = 3, ACT_LOGF = 4 };
template <int ACT> __device__ __forceinline__ float act_apply(float v, float lb) {
    if (ACT == ACT_GELU) return geluf_(v);
    if (ACT == ACT_SILU) return siluf_(v);
    if (ACT == ACT_SIGM) return sigmoidf_(v);
    if (ACT == ACT_LOGF) return __logf(lb + (1.0f - lb) * sigmoidf_(v));
    return v;
}
template <int ACT> __device__ __forceinline__ void epi16_store(const f32x4 (&acc)[2][2][4][2], bf16_t* base, int ldc, int row0, int col0, const float* lbp) {
    float lbv[2][8];
#pragma unroll
    for (int bj = 0; bj < 2; ++bj)
#pragma unroll
        for (int j = 0; j < 8; ++j) lbv[bj][j] = (ACT == ACT_LOGF) ? lbp[col0 + bj * HALF + j] : 0.f;
#pragma unroll
    for (int ai = 0; ai < 2; ++ai)
#pragma unroll
        for (int m = 0; m < 4; ++m) { bf16_t* rowp = base + (size_t)(row0 + ai * HALF + m * 16) * ldc + col0;
#pragma unroll
            for (int bj = 0; bj < 2; ++bj) { f32x4 v0 = acc[ai][bj][m][0], v1 = acc[ai][bj][m][1];
                asm volatile("; act %c2" : "+v"(v0), "+v"(v1) : "i"(ACT));
                float o[8];
#pragma unroll
                for (int j = 0; j < 4; ++j) { o[j] = act_apply<ACT>(v0[j], lbv[bj][j]); o[4 + j] = act_apply<ACT>(v1[j], lbv[bj][4 + j]); }
                u32x4 w;
                if (ACT == ACT_LOGF) { w.x = pk_f16(o[0], o[1]); w.y = pk_f16(o[2], o[3]); w.z = pk_f16(o[4], o[5]); w.w = pk_f16(o[6], o[7]); }
                else { w.x = cvt_pk_bf16(o[0], o[1]); w.y = cvt_pk_bf16(o[2], o[3]); w.z = cvt_pk_bf16(o[4], o[5]); w.w = cvt_pk_bf16(o[6], o[7]); }
                *(u32x4*)(rowp + bj * HALF) = w; } }
}
struct EpiSec {
    static constexpr bool PERM = true;
    bf16_t* d0; size_t sec_stride; int acts; int ldc, sec_cols; const float* lb;
    __device__ __forceinline__ void operator()(const f32x4 (&acc)[2][2][4][2], const Unit& u, int wr, int wc, int fr, int fq) const {
        { int t_ = lane_id(); asm volatile("" : "+v"(t_)); fr = t_ & 15; fq = (t_ >> 4) & 3; }
        const int colt = u.pn * BM, sec = colt / sec_cols, colin = colt - sec * sec_cols;
        bf16_t* base = d0 + (size_t)sec * sec_stride;
        const int a = (acts >> (4 * sec)) & 15;
        const int row0 = u.pm * BM + wr * 64 + fr, col0 = colin + wc * 32 + 8 * fq;
        if (a == ACT_NONE) epi16_store<ACT_NONE>(acc, base, ldc, row0, col0, lb);
        else if (a == ACT_GELU) epi16_store<ACT_GELU>(acc, base, ldc, row0, col0, lb);
        else if (a == ACT_SILU) epi16_store<ACT_SILU>(acc, base, ldc, row0, col0, lb);
        else if (a == ACT_SIGM) epi16_store<ACT_SIGM>(acc, base, ldc, row0, col0, lb);
        else epi16_store<ACT_LOGF>(acc, base, ldc, row0, col0, lb);
    }
};
enum { MODE_T = 0, MODE_M = 1, MODE_Z = 2, MODE_E = 3, MODE_PLE = 4, MODE_FIN = 5 };
__device__ __forceinline__ f32x4 ld_bf4(const bf16_t* p) { const u32x2 w = *(const u32x2*)p; return (f32x4){bf_lo(w.x), bf_hi(w.x), bf_lo(w.y), bf_hi(w.y)}; }
__device__ __forceinline__ void st_bf4(bf16_t* p, const f32x4 o) { u32x2 w; w.x = cvt_pk_bf16(o[0], o[1]); w.y = cvt_pk_bf16(o[2], o[3]); *(u32x2*)p = w; }
template <int MODE> struct EpiF32 {
    static constexpr bool PERM = false;
    float* out; const float* in; const bf16_t* g; const bf16_t* ib; int ldib; bf16_t* ob; int ldob;
    __device__ __forceinline__ void operator()(const f32x4 (&acc)[2][2][4][2], const Unit& u, int wr, int wc, int fr, int fq) const {
        { int t_ = lane_id(); asm volatile("" : "+v"(t_)); fr = t_ & 15; fq = (t_ >> 4) & 3; }
        const int row0 = u.pm * BM + wr * 64 + fr, col0 = u.pn * BM + wc * 32 + 4 * fq;
#pragma unroll
        for (int ai = 0; ai < 2; ++ai)
#pragma unroll
            for (int m = 0; m < 4; ++m) { const size_t r = (size_t)(row0 + ai * HALF + m * 16);
#pragma unroll
                for (int bj = 0; bj < 2; ++bj)
#pragma unroll
                    for (int n = 0; n < 2; ++n) { const int c = col0 + bj * HALF + n * 16; const f32x4 v = acc[ai][bj][m][n];
                        if (MODE == MODE_T) { st_bf4(ob + r * ldob + c, v * ld_bf4(g + r * 1024 + c)); }
                        else if (MODE == MODE_M) { st_bf4(ob + r * ldob + c, ld_bf4(ib + r * ldib + c) + v * ld_bf4(g + r * 1024 + c)); }
                        else if (MODE == MODE_Z) { const f32x4 xx = *(const f32x4*)(in + r * 1024 + c); st_bf4(ob + r * ldob + c, xx * ALPHA + v); }
                        else if (MODE == MODE_E) { st_bf4(ob + r * ldob + c, v); }
                        else if (MODE == MODE_PLE) { const f32x4 e = ld_bf4(ib + r * ldib + c); st_bf4(ob + r * ldob + c, (f32x4){sigmoidf_(v[0]) * e[0], sigmoidf_(v[1]) * e[1], sigmoidf_(v[2]) * e[2], sigmoidf_(v[3]) * e[3]}); }
                        else { const f32x4 x1 = ld_bf4(g + r * 1024 + c), pl = ld_bf4(ib + r * ldib + c); *(f32x4*)(out + r * 1024 + c) = x1 * ALPHA + pl + v; }
                    }
                asm volatile("" ::: "memory"); }
    }
};
__device__ __forceinline__ float dpp_f(float old, float src, const int ctrl) {
    return ctrl == 0x111 ? __int_as_float(__builtin_amdgcn_update_dpp(__float_as_int(old), __float_as_int(src), 0x111, 0xf, 0xf, false))
         : ctrl == 0x112 ? __int_as_float(__builtin_amdgcn_update_dpp(__float_as_int(old), __float_as_int(src), 0x112, 0xf, 0xf, false))
         : ctrl == 0x121 ? __int_as_float(__builtin_amdgcn_update_dpp(__float_as_int(old), __float_as_int(src), 0x121, 0xf, 0xf, false))
         :                 __int_as_float(__builtin_amdgcn_update_dpp(__float_as_int(old), __float_as_int(src), 0x122, 0xf, 0xf, false));
}
struct EpiConv {
    static constexpr bool PERM = true;
    bf16_t* act; const float* cw; const float* cb; float* GL; float* GF; float* VF; LAS float* X;
    __device__ __forceinline__ void operator()(const f32x4 (&acc)[2][2][4][2], const Unit& u, int wr, int wc, int fr, int fq) const {
        { const int t_ = lane_id(); fr = t_ & 15; fq = (t_ >> 4) & 3; }
        const int chl = wc * 32 + 8 * fq, ch0 = u.pn * 128 + chl;
        if (fr >= 14) {
#pragma unroll
            for (int ai = 0; ai < 2; ++ai) { LAS float* xp = X + ((ai * 2 + wr) * 2 + (fr - 14)) * 128 + chl; *(LAS f32x4*)xp = acc[ai][0][3][0]; *(LAS f32x4*)(xp + 4) = acc[ai][0][3][1]; }
            if (wr == 1) { float* gp = GL + ((size_t)u.pm * 2 + (fr - 14)) * 2816 + ch0; *(f32x4*)gp = acc[1][0][3][0]; *(f32x4*)(gp + 4) = acc[1][0][3][1]; }
        }
        if (wr == 0 && fr < 2) { float* gp = GF + ((size_t)u.pm * 2 + fr) * 2816 + ch0; *(f32x4*)gp = acc[0][0][0][0]; *(f32x4*)(gp + 4) = acc[0][0][0][1];
                                 float* vp = VF + ((size_t)u.pm * 2 + fr) * 2816 + ch0; *(f32x4*)vp = acc[0][1][0][0]; *(f32x4*)(vp + 4) = acc[0][1][0][1]; }
        asm volatile("s_waitcnt lgkmcnt(0)" ::: "memory"); __builtin_amdgcn_s_barrier(); asm volatile("" ::: "memory");
        float w0[8], w1[8], w2[8], bb[8];
#pragma unroll
        for (int h = 0; h < 2; ++h) { const f32x4 a = *(const f32x4*)(cw + ch0 + 4 * h), b = *(const f32x4*)(cw + 2816 + ch0 + 4 * h), c = *(const f32x4*)(cw + 2 * 2816 + ch0 + 4 * h), d = *(const f32x4*)(cb + ch0 + 4 * h);
#pragma unroll
            for (int j = 0; j < 4; ++j) { w0[4 * h + j] = a[j]; w1[4 * h + j] = b[j]; w2[4 * h + j] = c[j]; bb[4 * h + j] = d[j]; } }
#pragma unroll
        for (int ai = 0; ai < 2; ++ai) {
            float t1[8], t2[8];
            const int src = wr == 1 ? ai * 2 : (ai == 1 ? 1 : -1);
            if (src >= 0) { const LAS float* xa = X + (src * 2 + 1) * 128 + chl; const LAS float* xb = X + (src * 2 + 0) * 128 + chl;
                const f32x4 a0 = *(const LAS f32x4*)xa, a1 = *(const LAS f32x4*)(xa + 4), b0 = *(const LAS f32x4*)xb, b1 = *(const LAS f32x4*)(xb + 4);
#pragma unroll
                for (int j = 0; j < 4; ++j) { t1[j] = a0[j]; t1[4 + j] = a1[j]; t2[j] = fr == 0 ? b0[j] : a0[j]; t2[4 + j] = fr == 0 ? b1[j] : a1[j]; } }
            else {
#pragma unroll
                for (int k = 0; k < 8; ++k) { t1[k] = 0.f; t2[k] = 0.f; } }
#pragma unroll
            for (int m = 0; m < 4; ++m) {
                float o[8];
#pragma unroll
                for (int n = 0; n < 2; ++n)
#pragma unroll
                    for (int j = 0; j < 4; ++j) { const int k = 4 * n + j; const float g = acc[ai][0][m][n][j];
                        if (m > 0) { const float gp = acc[ai][0][m - 1][n][j]; t1[k] = dpp_f(0.f, gp, 0x121); t2[k] = dpp_f(0.f, gp, 0x122); }
                        const float p1 = dpp_f(t1[k], g, 0x111), p2 = dpp_f(t2[k], g, 0x112);
                        const float y = w0[k] * p2 + w1[k] * p1 + w2[k] * g + bb[k];
                        o[k] = geluf_(y) * acc[ai][1][m][n][j]; }
                u32x4 w; w.x = cvt_pk_bf16(o[0], o[1]); w.y = cvt_pk_bf16(o[2], o[3]); w.z = cvt_pk_bf16(o[4], o[5]); w.w = cvt_pk_bf16(o[6], o[7]);
                *(u32x4*)(act + (size_t)(u.pm * BM + ai * HALF + wr * 64 + m * 16 + fr) * 2816 + ch0) = w;
            }
        }
    }
};
}

__device__ __forceinline__ void p0_transpose_item(const float* W, int K, int N, bf16_t* WT, int row_off, LAS float* scr, int item, int lane) {
    const int nblk = N / 32, kb = item / nblk, nb = item % nblk, k0 = 64 * kb, n0 = 32 * nb;
#pragma unroll 8
    for (int i = 0; i < 32; ++i) { const int kk = 2 * i + (lane >> 5); scr[kk * 33 + (lane & 31)] = W[(size_t)(k0 + kk) * N + n0 + (lane & 31)]; }
    asm volatile("s_waitcnt lgkmcnt(0)" ::: "memory");
    const int c = lane & 7;
#pragma unroll
    for (int j = 0; j < 4; ++j) { const int n = (lane >> 3) + 8 * j; const LAS float* s = scr + (8 * c) * 33 + n;
        u32x4 o; o.x = cvt_pk_bf16(s[0 * 33], s[1 * 33]); o.y = cvt_pk_bf16(s[2 * 33], s[3 * 33]); o.z = cvt_pk_bf16(s[4 * 33], s[5 * 33]); o.w = cvt_pk_bf16(s[6 * 33], s[7 * 33]);
        *(u32x4*)(WT + (size_t)(row_off + n0 + n) * K + k0 + 8 * c) = o; }
    asm volatile("s_waitcnt lgkmcnt(0)" ::: "memory");
}
__device__ __forceinline__ void cvt_f32_bf16(const float* src, bf16_t* dst, size_t nvec, size_t gt, size_t nthreads) {
    size_t i = gt;
    for (; i + 3 * nthreads < nvec; i += 4 * nthreads) { f32x4 a[4], b[4];
#pragma unroll
        for (int u = 0; u < 4; ++u) { a[u] = *(const f32x4*)(src + (i + u * nthreads) * 8); b[u] = *(const f32x4*)(src + (i + u * nthreads) * 8 + 4); }
#pragma unroll
        for (int u = 0; u < 4; ++u) { u32x4 o; o.x = cvt_pk_bf16(a[u][0], a[u][1]); o.y = cvt_pk_bf16(a[u][2], a[u][3]); o.z = cvt_pk_bf16(b[u][0], b[u][1]); o.w = cvt_pk_bf16(b[u][2], b[u][3]); *(u32x4*)(dst + (i + u * nthreads) * 8) = o; } }
    for (; i < nvec; i += nthreads) { const f32x4 a = *(const f32x4*)(src + i * 8), b = *(const f32x4*)(src + i * 8 + 4);
        u32x4 o; o.x = cvt_pk_bf16(a[0], a[1]); o.y = cvt_pk_bf16(a[2], a[3]); o.z = cvt_pk_bf16(b[0], b[1]); o.w = cvt_pk_bf16(b[2], b[3]); *(u32x4*)(dst + i * 8) = o; }
}

__device__ __forceinline__ bf16x8 ldfrag(const LAS bf16_t* base, int row, int ld, int k) { return *(const LAS bf16x8*)(base + row * ld + k); }

__device__ __forceinline__ void hgrn_pass_b2(LAS unsigned char* lds, const _Float16* LOGF, const bf16_t* I, bf16_t* U, float* Dtab, int itemA, int itemB, const int wv) {
    int tid_ = wv * 64 + lane_id(); asm volatile("" : "+v"(tid_)); const int tid = tid_, lane = tid & 63, w = tid >> 6;
    const int e = tid & 127, part = tid >> 7;
    float lf[2][16], cum[2][16]; unsigned short iv[2][16]; float sum[2];
#pragma unroll
    for (int u = 0; u < 2; ++u) { const int item = u ? itemB : itemA; const int c = item & 63, bh = item >> 6, h = bh & 7, b = bh >> 3; const size_t r0 = (size_t)b * SEQ + (size_t)c * 64;
#pragma unroll
        for (int j = 0; j < 16; ++j) { const size_t off = (r0 + 16 * part + j) * 1024 + h * 128 + e; lf[u][j] = (float)LOGF[off]; iv[u][j] = I[off]; } }
#pragma unroll
    for (int u = 0; u < 2; ++u) { LAS bf16_t* kT = (LAS bf16_t*)(lds + u * 38912); LAS bf16_t* iT = kT + 128 * 72; LAS float* tot = (LAS float*)(iT + 128 * 72);
        float s = 0.f;
#pragma unroll
        for (int j = 0; j < 16; ++j) { s += lf[u][j]; cum[u][j] = s; }
        sum[u] = s; tot[part * 128 + e] = s;
        u32x4 w0, w1;
        w0.x = iv[u][0] | ((unsigned)iv[u][1] << 16); w0.y = iv[u][2] | ((unsigned)iv[u][3] << 16); w0.z = iv[u][4] | ((unsigned)iv[u][5] << 16); w0.w = iv[u][6] | ((unsigned)iv[u][7] << 16);
        w1.x = iv[u][8] | ((unsigned)iv[u][9] << 16); w1.y = iv[u][10] | ((unsigned)iv[u][11] << 16); w1.z = iv[u][12] | ((unsigned)iv[u][13] << 16); w1.w = iv[u][14] | ((unsigned)iv[u][15] << 16);
        *(LAS u32x4*)(iT + e * 72 + 16 * part) = w0; *(LAS u32x4*)(iT + e * 72 + 16 * part + 8) = w1; }
    __syncthreads();
#pragma unroll
    for (int u = 0; u < 2; ++u) { const int item = u ? itemB : itemA; LAS bf16_t* kT = (LAS bf16_t*)(lds + u * 38912); LAS bf16_t* iT = kT + 128 * 72; LAS float* tot = (LAS float*)(iT + 128 * 72);
        float off = 0.f, total = 0.f;
#pragma unroll
        for (int p = 0; p < 4; ++p) { const float t = tot[p * 128 + e]; if (p < part) off += t; total += t; }
        float kp[16];
#pragma unroll
        for (int j = 0; j < 16; ++j) kp[j] = (1.0f - __expf(lf[u][j])) * __expf(total - (off + cum[u][j]));
        u32x4 w0, w1;
        w0.x = cvt_pk_bf16(kp[0], kp[1]); w0.y = cvt_pk_bf16(kp[2], kp[3]); w0.z = cvt_pk_bf16(kp[4], kp[5]); w0.w = cvt_pk_bf16(kp[6], kp[7]);
        w1.x = cvt_pk_bf16(kp[8], kp[9]); w1.y = cvt_pk_bf16(kp[10], kp[11]); w1.z = cvt_pk_bf16(kp[12], kp[13]); w1.w = cvt_pk_bf16(kp[14], kp[15]);
        *(LAS u32x4*)(kT + e * 72 + 16 * part) = w0; *(LAS u32x4*)(kT + e * 72 + 16 * part + 8) = w1;
        if (part == 0) Dtab[(size_t)item * 128 + e] = __expf(total); }
    __syncthreads();
#pragma unroll
    for (int u = 0; u < 2; ++u) { const int item = u ? itemB : itemA; const LAS bf16_t* kT = (const LAS bf16_t*)(lds + u * 38912); const LAS bf16_t* iT = kT + 128 * 72;
        bf16x8 yf[2];
#pragma unroll
        for (int ks = 0; ks < 2; ++ks) yf[ks] = ldfrag(iT, 16 * w + (lane & 15), 72, ks * 32 + (lane >> 4) * 8);
        bf16_t* Ub = U + (size_t)item * 16384 + (size_t)(16 * w + (lane & 15)) * 128 + (lane >> 4) * 4;
#pragma unroll
        for (int te = 0; te < 8; ++te) { f32x4 acc = {0.f, 0.f, 0.f, 0.f};
#pragma unroll
            for (int ks = 0; ks < 2; ++ks) { const bf16x8 xf = ldfrag(kT, 16 * te + (lane & 15), 72, ks * 32 + (lane >> 4) * 8); acc = __builtin_amdgcn_mfma_f32_16x16x32_bf16(xf, yf[ks], acc, 0, 0, 0); }
            u32x2 o; o.x = cvt_pk_bf16(acc[0], acc[1]); o.y = cvt_pk_bf16(acc[2], acc[3]); *(u32x2*)(Ub + 16 * te) = o; } }
    __syncthreads();
}

__device__ __forceinline__ void hgrn_scan(bf16_t* U, const float* Dtab, int gt, int nthreads) {
    for (int idx = gt; idx < 64 * 2048; idx += nthreads) {
        const int bh = idx >> 11, el = (idx & 2047) * 8, e8 = el & 127;
        float S[8];
#pragma unroll
        for (int j = 0; j < 8; ++j) S[j] = 0.f;
#pragma unroll 8
        for (int c = 0; c < 64; ++c) { const size_t item = (size_t)bh * 64 + c;
            u32x4* up = (u32x4*)(U + item * 16384 + el); const u32x4 uv = *up;
            const f32x4 d0 = *(const f32x4*)(Dtab + item * 128 + e8), d1 = *(const f32x4*)(Dtab + item * 128 + e8 + 4);
            u32x4 o; o.x = cvt_pk_bf16(S[0], S[1]); o.y = cvt_pk_bf16(S[2], S[3]); o.z = cvt_pk_bf16(S[4], S[5]); o.w = cvt_pk_bf16(S[6], S[7]); *up = o;
            S[0] = d0[0] * S[0] + bf_lo(uv.x); S[1] = d0[1] * S[1] + bf_hi(uv.x); S[2] = d0[2] * S[2] + bf_lo(uv.y); S[3] = d0[3] * S[3] + bf_hi(uv.y);
            S[4] = d1[0] * S[4] + bf_lo(uv.z); S[5] = d1[1] * S[5] + bf_hi(uv.z); S[6] = d1[2] * S[6] + bf_lo(uv.w); S[7] = d1[3] * S[7] + bf_hi(uv.w); }
    }
}

__device__ __forceinline__ void hgrn_pass_ad(LAS unsigned char* lds, bf16_t* Q, const _Float16* LOGF, const bf16_t* I, const bf16_t* OG, const bf16_t* U, const float* gnorm, int item, const int wv) {
    int tid_ = wv * 64 + lane_id(); asm volatile("" : "+v"(tid_)); const int tid = tid_, lane = tid & 63, w = tid >> 6;
    const int c = item & 63, bh = item >> 6, h = bh & 7, b = bh >> 3;
    const size_t r0 = (size_t)b * SEQ + (size_t)c * 64;
    LAS bf16_t* qs = (LAS bf16_t*)lds;
    LAS bf16_t* ks_ = (LAS bf16_t*)(lds + 17408);
    LAS bf16_t* iT = (LAS bf16_t*)(lds + 34816);
    LAS bf16_t* ST = (LAS bf16_t*)(lds + 53248);
    LAS bf16_t* at = (LAS bf16_t*)(lds + 88064);
    LAS float* Cb = (LAS float*)(lds + 97280);
    LAS float* tot = (LAS float*)(lds + 131072);
    const int e = tid & 127, part = tid >> 7;
    u32x4 q8h[2], l8h[2];
#pragma unroll
    for (int rr = 0; rr < 2; ++rr) { const size_t off = (r0 + (tid >> 4) + 32 * rr) * 1024 + h * 128 + (tid & 15) * 8; q8h[rr] = *(const u32x4*)(Q + off); l8h[rr] = *(const u32x4*)((const bf16_t*)LOGF + off); }
    const size_t ogoff = (r0 + (tid >> 3)) * 1024 + h * 128 + (tid & 7) * 16;
    const u32x4 g0 = *(const u32x4*)(OG + ogoff), g1 = *(const u32x4*)(OG + ogoff + 8);
    float cum[16];
    { float s = 0.f; unsigned short iv[16];
#pragma unroll
      for (int j = 0; j < 16; ++j) { const size_t off = (r0 + 16 * part + j) * 1024 + h * 128 + e; s += (float)LOGF[off]; cum[j] = s; iv[j] = I[off]; }
      tot[part * 128 + e] = s;
      u32x4 w0, w1;
      w0.x = iv[0] | ((unsigned)iv[1] << 16); w0.y = iv[2] | ((unsigned)iv[3] << 16); w0.z = iv[4] | ((unsigned)iv[5] << 16); w0.w = iv[6] | ((unsigned)iv[7] << 16);
      w1.x = iv[8] | ((unsigned)iv[9] << 16); w1.y = iv[10] | ((unsigned)iv[11] << 16); w1.z = iv[12] | ((unsigned)iv[13] << 16); w1.w = iv[14] | ((unsigned)iv[15] << 16);
      *(LAS u32x4*)(iT + e * 72 + 16 * part) = w0; *(LAS u32x4*)(iT + e * 72 + 16 * part + 8) = w1; }
#pragma unroll
    for (int k = 0; k < 4; ++k) { const int idx = tid + 512 * k, v = idx >> 4, e8 = (idx & 15) * 8;
        *(LAS u32x4*)(ST + v * 136 + e8) = *(const u32x4*)(U + (size_t)item * 16384 + v * 128 + e8); }
    __syncthreads();
    { float off = 0.f;
#pragma unroll
      for (int p = 0; p < 3; ++p) { const float t = tot[p * 128 + e]; if (p < part) off += t; }
#pragma unroll
      for (int j = 0; j < 16; ++j) Cb[(16 * part + j) * 132 + e] = off + cum[j]; }
    __syncthreads();
#pragma unroll
    for (int rr = 0; rr < 2; ++rr) { const int t = (tid >> 4) + 32 * rr, e8 = (tid & 15) * 8;
        const u32x4 q8 = q8h[rr]; const u32x4 l8 = l8h[rr];
        const f32x4 c0 = *(const LAS f32x4*)(Cb + t * 132 + e8), c1 = *(const LAS f32x4*)(Cb + t * 132 + e8 + 4);
        float qv[8] = {bf_lo(q8.x), bf_hi(q8.x), bf_lo(q8.y), bf_hi(q8.y), bf_lo(q8.z), bf_hi(q8.z), bf_lo(q8.w), bf_hi(q8.w)};
        float lv[8] = {h_lo(l8.x), h_hi(l8.x), h_lo(l8.y), h_hi(l8.y), h_lo(l8.z), h_hi(l8.z), h_lo(l8.w), h_hi(l8.w)};
        float cv[8] = {c0[0], c0[1], c0[2], c0[3], c1[0], c1[1], c1[2], c1[3]};
        float qt[8], kt[8];
#pragma unroll
        for (int j = 0; j < 8; ++j) { qt[j] = qv[j] * __expf(cv[j]); kt[j] = (1.0f - __expf(lv[j])) * __expf(-cv[j]); }
        u32x4 wq, wk;
        wq.x = cvt_pk_bf16(qt[0], qt[1]); wq.y = cvt_pk_bf16(qt[2], qt[3]); wq.z = cvt_pk_bf16(qt[4], qt[5]); wq.w = cvt_pk_bf16(qt[6], qt[7]);
        wk.x = cvt_pk_bf16(kt[0], kt[1]); wk.y = cvt_pk_bf16(kt[2], kt[3]); wk.z = cvt_pk_bf16(kt[4], kt[5]); wk.w = cvt_pk_bf16(kt[6], kt[7]);
        *(LAS u32x4*)(qs + t * 136 + e8) = wq; *(LAS u32x4*)(ks_ + t * 136 + e8) = wk; }
    __syncthreads();
    { const int tt = w >> 1;
#pragma unroll
      for (int ts2 = 0; ts2 < 2; ++ts2) { const int ts = 2 * (w & 1) + ts2; f32x4 acc = {0.f, 0.f, 0.f, 0.f};
#pragma unroll
          for (int kk = 0; kk < 4; ++kk) { const bf16x8 xf = ldfrag(ks_, 16 * ts + (lane & 15), 136, kk * 32 + (lane >> 4) * 8), yf = ldfrag(qs, 16 * tt + (lane & 15), 136, kk * 32 + (lane >> 4) * 8);
              acc = __builtin_amdgcn_mfma_f32_16x16x32_bf16(xf, yf, acc, 0, 0, 0); }
          const int t = 16 * tt + (lane & 15), s0 = 16 * ts + (lane >> 4) * 4;
          float a0 = (s0 + 0 <= t) ? acc[0] : 0.f, a1 = (s0 + 1 <= t) ? acc[1] : 0.f, a2 = (s0 + 2 <= t) ? acc[2] : 0.f, a3 = (s0 + 3 <= t) ? acc[3] : 0.f;
          u32x2 o; o.x = cvt_pk_bf16(a0, a1); o.y = cvt_pk_bf16(a2, a3); *(LAS u32x2*)(at + t * 72 + s0) = o; } }
    __syncthreads();
    { bf16x8 xi[2], xs[4];
#pragma unroll
      for (int kk = 0; kk < 2; ++kk) xi[kk] = ldfrag(iT, 16 * w + (lane & 15), 72, kk * 32 + (lane >> 4) * 8);
#pragma unroll
      for (int kk = 0; kk < 4; ++kk) xs[kk] = ldfrag(ST, 16 * w + (lane & 15), 136, kk * 32 + (lane >> 4) * 8);
#pragma unroll
      for (int tt = 0; tt < 4; ++tt) { f32x4 acc = {0.f, 0.f, 0.f, 0.f};
#pragma unroll
          for (int kk = 0; kk < 2; ++kk) { const bf16x8 yf = ldfrag(at, 16 * tt + (lane & 15), 72, kk * 32 + (lane >> 4) * 8); acc = __builtin_amdgcn_mfma_f32_16x16x32_bf16(xi[kk], yf, acc, 0, 0, 0); }
#pragma unroll
          for (int kk = 0; kk < 4; ++kk) { const bf16x8 yf = ldfrag(qs, 16 * tt + (lane & 15), 136, kk * 32 + (lane >> 4) * 8); acc = __builtin_amdgcn_mfma_f32_16x16x32_bf16(xs[kk], yf, acc, 0, 0, 0); }
          *(LAS f32x4*)(Cb + (16 * tt + (lane & 15)) * 132 + 16 * w + (lane >> 4) * 4) = acc; } }
    __syncthreads();
    { const int t = tid >> 3, v16 = (tid & 7) * 16; float ov[16]; float ss = 0.f;
#pragma unroll
      for (int k = 0; k < 4; ++k) { const f32x4 x = *(const LAS f32x4*)(Cb + t * 132 + v16 + 4 * k); ov[4 * k] = x[0]; ov[4 * k + 1] = x[1]; ov[4 * k + 2] = x[2]; ov[4 * k + 3] = x[3]; ss += (x[0] * x[0] + x[1] * x[1]) + (x[2] * x[2] + x[3] * x[3]); }
      { const int l_ = lane_id(); ss += shfl_xor_l(ss, 1, l_); ss += shfl_xor_l(ss, 2, l_); ss += shfl_xor_l(ss, 4, l_); }
      const float rstd = rsqrtf(ss * (1.0f / 128.0f) + RMS_EPS);
      const size_t off = (r0 + t) * 1024 + h * 128 + v16;
      const float gg[16] = {bf_lo(g0.x), bf_hi(g0.x), bf_lo(g0.y), bf_hi(g0.y), bf_lo(g0.z), bf_hi(g0.z), bf_lo(g0.w), bf_hi(g0.w), bf_lo(g1.x), bf_hi(g1.x), bf_lo(g1.y), bf_hi(g1.y), bf_lo(g1.z), bf_hi(g1.z), bf_lo(g1.w), bf_hi(g1.w)};
      float y[16];
#pragma unroll
      for (int k = 0; k < 4; ++k) { const f32x4 gn = *(const f32x4*)(gnorm + h * 128 + v16 + 4 * k);
#pragma unroll
          for (int j = 0; j < 4; ++j) y[4 * k + j] = ov[4 * k + j] * rstd * gn[j] * gg[4 * k + j]; }
      u32x4 o0, o1;
      o0.x = cvt_pk_bf16(y[0], y[1]); o0.y = cvt_pk_bf16(y[2], y[3]); o0.z = cvt_pk_bf16(y[4], y[5]); o0.w = cvt_pk_bf16(y[6], y[7]);
      o1.x = cvt_pk_bf16(y[8], y[9]); o1.y = cvt_pk_bf16(y[10], y[11]); o1.z = cvt_pk_bf16(y[12], y[13]); o1.w = cvt_pk_bf16(y[14], y[15]);
      *(u32x4*)(Q + off) = o0; *(u32x4*)(Q + off + 8) = o1; }
    __syncthreads();
}

__device__ __forceinline__ void sgu_item(LAS unsigned char* lds, bf16_t* UU, const bf16_t* V, const float* w_s, const float* b_s, const float* gv, const float* bv, int nb, const int wv) {
    int tid_ = wv * 64 + lane_id(); asm volatile("" : "+v"(tid_)); const int tid = tid_, lane = tid & 63, w = tid >> 6;
    const size_t r0 = (size_t)nb * 128;
    LAS bf16_t* vnT = (LAS bf16_t*)lds;
    LAS bf16_t* Wl = (LAS bf16_t*)(lds + 34816);
    LAS float* stats = (LAS float*)(lds + 69632);
    for (int rr = 0; rr < 16; ++rr) { const int row = 16 * w + rr; const bf16_t* vp = V + (r0 + row) * 1024 + lane * 16;
        const u32x4 a = *(const u32x4*)vp, b = *(const u32x4*)(vp + 8);
        float x[16] = {bf_lo(a.x), bf_hi(a.x), bf_lo(a.y), bf_hi(a.y), bf_lo(a.z), bf_hi(a.z), bf_lo(a.w), bf_hi(a.w), bf_lo(b.x), bf_hi(b.x), bf_lo(b.y), bf_hi(b.y), bf_lo(b.z), bf_hi(b.z), bf_lo(b.w), bf_hi(b.w)};
        float s = 0.f;
#pragma unroll
        for (int j = 0; j < 16; ++j) s += x[j];
        const float mean = wave_sum(s) * (1.0f / 1024.0f); float q = 0.f;
#pragma unroll
        for (int j = 0; j < 16; ++j) { const float d = x[j] - mean; q += d * d; }
        const float rstd = rsqrtf(wave_sum(q) * (1.0f / 1024.0f) + LN_EPS);
        if (lane == 0) { stats[row * 2] = mean; stats[row * 2 + 1] = rstd; } }
    __syncthreads();
    for (int g = 0; g < 8; ++g) {
        { const int c = tid & 127, part = tid >> 7; const float gam = gv[g * 128 + c], bet = bv[g * 128 + c];
#pragma unroll
          for (int k = 0; k < 4; ++k) { float vn[8];
#pragma unroll
              for (int j = 0; j < 8; ++j) { const int s = 32 * part + 8 * k + j; const float x = bf2f(V[(r0 + s) * 1024 + g * 128 + c]); vn[j] = (x - stats[s * 2]) * stats[s * 2 + 1] * gam + bet; }
              u32x4 o; o.x = cvt_pk_bf16(vn[0], vn[1]); o.y = cvt_pk_bf16(vn[2], vn[3]); o.z = cvt_pk_bf16(vn[4], vn[5]); o.w = cvt_pk_bf16(vn[6], vn[7]);
              *(LAS u32x4*)(vnT + c * 136 + 32 * part + 8 * k) = o; } }
#pragma unroll
        for (int k = 0; k < 8; ++k) { const int idx = tid + 512 * k, t = idx >> 5, s4 = (idx & 31) * 4;
            f32x4 ww = *(const f32x4*)(w_s + (size_t)g * 16384 + t * 128 + s4);
            if (t < 64 && s4 >= 64) ww = (f32x4){0.f, 0.f, 0.f, 0.f};
            u32x2 o; o.x = cvt_pk_bf16(ww[0], ww[1]); o.y = cvt_pk_bf16(ww[2], ww[3]); *(LAS u32x2*)(Wl + t * 136 + s4) = o; }
        __syncthreads();
        bf16x8 xf[4];
#pragma unroll
        for (int kk = 0; kk < 4; ++kk) xf[kk] = ldfrag(vnT, 16 * w + (lane & 15), 136, kk * 32 + (lane >> 4) * 8);
#pragma unroll
        for (int tt = 0; tt < 8; ++tt) { f32x4 acc = {0.f, 0.f, 0.f, 0.f};
#pragma unroll
            for (int kk = 0; kk < 4; ++kk) { const bf16x8 yf = ldfrag(Wl, 16 * tt + (lane & 15), 136, kk * 32 + (lane >> 4) * 8); acc = __builtin_amdgcn_mfma_f32_16x16x32_bf16(xf[kk], yf, acc, 0, 0, 0); }
            const int t = 16 * tt + (lane & 15); const float bsv = b_s[g * 128 + t];
            bf16_t* up = UU + (r0 + t) * 1024 + g * 128 + 16 * w + (lane >> 4) * 4;
            const u32x2 uu = *(const u32x2*)up;
            u32x2 o; o.x = cvt_pk_bf16(bf_lo(uu.x) * (acc[0] + bsv), bf_hi(uu.x) * (acc[1] + bsv)); o.y = cvt_pk_bf16(bf_lo(uu.y) * (acc[2] + bsv), bf_hi(uu.y) * (acc[3] + bsv));
            *(u32x2*)up = o; }
        __syncthreads();
    }
}

template <int MODE> __device__ __forceinline__ void ln_row2(float* row0, float* row1, bf16_t* xb0, bf16_t* xb1, const float* g, const float* b, int lane) {
    f32x4* xr0 = (f32x4*)row0 + lane; f32x4* xr1 = (f32x4*)row1 + lane; f32x4 v0[4], v1[4]; float s0 = 0.f, s1 = 0.f;
#pragma unroll
    for (int j = 0; j < 4; ++j) { v0[j] = xr0[64 * j]; v1[j] = xr1[64 * j]; }
#pragma unroll
    for (int j = 0; j < 4; ++j) { s0 += (v0[j][0] + v0[j][1]) + (v0[j][2] + v0[j][3]); s1 += (v1[j][0] + v1[j][1]) + (v1[j][2] + v1[j][3]); }
    const float m0 = wave_sum(s0) * (1.f / 1024.f), m1 = wave_sum(s1) * (1.f / 1024.f); float q0 = 0.f, q1 = 0.f;
#pragma unroll
    for (int j = 0; j < 4; ++j) { v0[j] = v0[j] - m0; v1[j] = v1[j] - m1; q0 += (v0[j][0] * v0[j][0] + v0[j][1] * v0[j][1]) + (v0[j][2] * v0[j][2] + v0[j][3] * v0[j][3]); q1 += (v1[j][0] * v1[j][0] + v1[j][1] * v1[j][1]) + (v1[j][2] * v1[j][2] + v1[j][3] * v1[j][3]); }
    const float r0 = rsqrtf(wave_sum(q0) * (1.f / 1024.f) + LN_EPS), r1 = rsqrtf(wave_sum(q1) * (1.f / 1024.f) + LN_EPS);
#pragma unroll
    for (int j = 0; j < 4; ++j) { const f32x4 gg = *((const f32x4*)g + lane + 64 * j), bb = *((const f32x4*)b + lane + 64 * j); const f32x4 y0 = v0[j] * r0 * gg + bb, y1 = v1[j] * r1 * gg + bb;
        if (MODE == 0) { u32x2 o; o.x = cvt_pk_bf16(y0[0], y0[1]); o.y = cvt_pk_bf16(y0[2], y0[3]); *((u32x2*)xb0 + lane + 64 * j) = o; xr0[64 * j] = y0 * ALPHA;
                         u32x2 p; p.x = cvt_pk_bf16(y1[0], y1[1]); p.y = cvt_pk_bf16(y1[2], y1[3]); *((u32x2*)xb1 + lane + 64 * j) = p; xr1[64 * j] = y1 * ALPHA; }
        else { xr0[64 * j] = y0; xr1[64 * j] = y1; } }
}

__device__ __forceinline__ void ln1_rows_bf16(const bf16_t* z0, const bf16_t* z1, bf16_t* x0, bf16_t* x1, const float* g, const float* b, int lane) {
    float v[2][16];
#pragma unroll
    for (int u = 0; u < 2; ++u) { const bf16_t* zp = (u ? z1 : z0) + lane * 16; const u32x4 a = *(const u32x4*)zp, c = *(const u32x4*)(zp + 8);
        v[u][0] = bf_lo(a.x); v[u][1] = bf_hi(a.x); v[u][2] = bf_lo(a.y); v[u][3] = bf_hi(a.y); v[u][4] = bf_lo(a.z); v[u][5] = bf_hi(a.z); v[u][6] = bf_lo(a.w); v[u][7] = bf_hi(a.w);
        v[u][8] = bf_lo(c.x); v[u][9] = bf_hi(c.x); v[u][10] = bf_lo(c.y); v[u][11] = bf_hi(c.y); v[u][12] = bf_lo(c.z); v[u][13] = bf_hi(c.z); v[u][14] = bf_lo(c.w); v[u][15] = bf_hi(c.w); }
    float gg[16], bb[16];
#pragma unroll
    for (int k = 0; k < 4; ++k) { const f32x4 g4 = *(const f32x4*)(g + lane * 16 + 4 * k), b4 = *(const f32x4*)(b + lane * 16 + 4 * k);
#pragma unroll
        for (int j = 0; j < 4; ++j) { gg[4 * k + j] = g4[j]; bb[4 * k + j] = b4[j]; } }
#pragma unroll
    for (int u = 0; u < 2; ++u) { float s = 0.f;
#pragma unroll
        for (int j = 0; j < 16; ++j) s += v[u][j];
        const float mean = wave_sum(s) * (1.f / 1024.f); float q = 0.f;
#pragma unroll
        for (int j = 0; j < 16; ++j) { v[u][j] -= mean; q += v[u][j] * v[u][j]; }
        const float rstd = rsqrtf(wave_sum(q) * (1.f / 1024.f) + LN_EPS);
        float y[16];
#pragma unroll
        for (int j = 0; j < 16; ++j) y[j] = v[u][j] * rstd * gg[j] + bb[j];
        u32x4 o0, o1;
        o0.x = cvt_pk_bf16(y[0], y[1]); o0.y = cvt_pk_bf16(y[2], y[3]); o0.z = cvt_pk_bf16(y[4], y[5]); o0.w = cvt_pk_bf16(y[6], y[7]);
        o1.x = cvt_pk_bf16(y[8], y[9]); o1.y = cvt_pk_bf16(y[10], y[11]); o1.z = cvt_pk_bf16(y[12], y[13]); o1.w = cvt_pk_bf16(y[14], y[15]);
        bf16_t* xp = (u ? x1 : x0) + lane * 16; *(u32x4*)xp = o0; *(u32x4*)(xp + 8) = o1; }
}

__device__ __forceinline__ void conv_fixup(bf16_t* ACT, const float* GL, const float* GF, const float* VF, const float* cw, const float* cb, int g_t, int nth) {
    for (int task = g_t; task < 128 * 2 * 704; task += nth) { const int ch = (task % 704) * 4, rr = (task / 704) & 1, pm = task / 1408;
        if ((pm & 15) == 0) continue;
        const float* gl = GL + (size_t)(pm - 1) * 2 * 2816 + ch; const float* gf = GF + (size_t)pm * 2 * 2816 + ch;
        const f32x4 a = rr == 0 ? *(const f32x4*)gl : *(const f32x4*)(gl + 2816), b = rr == 0 ? *(const f32x4*)(gl + 2816) : *(const f32x4*)gf, c = rr == 0 ? *(const f32x4*)gf : *(const f32x4*)(gf + 2816);
        const f32x4 v = *(const f32x4*)(VF + ((size_t)pm * 2 + rr) * 2816 + ch);
        const f32x4 w0 = *(const f32x4*)(cw + ch), w1 = *(const f32x4*)(cw + 2816 + ch), w2 = *(const f32x4*)(cw + 2 * 2816 + ch), bb = *(const f32x4*)(cb + ch);
        const f32x4 y = w0 * a + w1 * b + w2 * c + bb;
        pg8::st_bf4(ACT + (size_t)(pm * 256 + rr) * 2816 + ch, (f32x4){geluf_(y[0]) * v[0], geluf_(y[1]) * v[1], geluf_(y[2]) * v[2], geluf_(y[3]) * v[3]}); }
}

struct Args { const float* in[21]; float* out; unsigned char* ws; };

typedef const Args __attribute__((address_space(4))) * ArgsP;
__device__ __forceinline__ ArgsP get_args() { ArgsP p = (ArgsP)__builtin_amdgcn_kernarg_segment_ptr(); asm volatile("" : "+s"(p)); return p; }
#define WSP(T, off) ((T*)(ap->ws + (off)))

#define XB_TMO      128
#define XB_XCNT(j)  (256  + 64 * (j))
#define XB_XSUB(j)  (1280 + 64 * (j))
#define XB_XGEN(j)  (2304 + 64 * (j))
#define XB_TOP      3328
#define XB_TOPGEN   3392
#define XCD_BAR_WORDS 3456
#define XB_SPIN_CAP (1u << 22)
__device__ __forceinline__ unsigned xb_ld(unsigned* p)              { return __hip_atomic_load(p, __ATOMIC_RELAXED, __HIP_MEMORY_SCOPE_AGENT); }
__device__ __forceinline__ unsigned xb_add(unsigned* p, unsigned v) { return __hip_atomic_fetch_add(p, v, __ATOMIC_RELAXED, __HIP_MEMORY_SCOPE_AGENT); }
__device__ __forceinline__ unsigned xb_xcc_id() { return (unsigned)__builtin_amdgcn_s_getreg((3 << 11) | 20) & 0xFu; }
#define XB_SPIN(cond, bar) do { unsigned _sp = 0; while (cond) { __builtin_amdgcn_s_sleep(1); \
    if ((++_sp & 255u) == 0u) { if (xb_ld(&(bar)[XB_TMO])) break; if (_sp > XB_SPIN_CAP) { atomicAdd(&(bar)[XB_TMO], 1u); break; } } } } while (0)
struct XcdBarrier { unsigned* bar; unsigned x; volatile LAS unsigned* st; };
__device__ __forceinline__ XcdBarrier xcd_barrier_post(unsigned* bar, volatile LAS unsigned* st) {
    XcdBarrier b; b.bar = bar; b.x = xb_xcc_id(); b.st = st;
    if (threadIdx.x == 0) (void)xb_add(&bar[XB_XCNT(b.x)], 1u);
    return b;
}
__device__ __forceinline__ void xcd_barrier_complete(unsigned* bar, unsigned x, unsigned& nloc, unsigned& nx) {
    const unsigned Gn = gridDim.x * gridDim.y * gridDim.z;
    unsigned sum, cnt, mine, sp = 0u;
    for (;;) {
        sum = 0u; cnt = 0u; mine = 0u;
#pragma unroll
        for (unsigned j = 0; j < 16; ++j) { const unsigned c = xb_ld(&bar[XB_XCNT(j)]); sum += c; cnt += (c > 0u) ? 1u : 0u; mine = (j == x) ? c : mine; }
        if (sum == Gn) break;
        __builtin_amdgcn_s_sleep(1);
        if ((++sp & 255u) == 0u) { if (xb_ld(&bar[XB_TMO])) break; if (sp > XB_SPIN_CAP) { atomicAdd(&bar[XB_TMO], 1u); break; } }
    }
    nloc = mine > 0u ? mine : 1u; nx = cnt > 0u ? cnt : 1u;
}
__device__ __forceinline__ void xcd_barrier(const XcdBarrier& b, const bool leader) {
    asm volatile("s_waitcnt vmcnt(0)" ::: "memory");
    __syncthreads();
    if (leader) {
        unsigned* bar = b.bar;
        __builtin_amdgcn_s_waitcnt(0);
        unsigned nloc = b.st[0], nx = b.st[1];
        if (nloc == 0u) { xcd_barrier_complete(bar, b.x, nloc, nx); b.st[0] = nloc; b.st[1] = nx; }
        const unsigned old = xb_add(&bar[XB_XSUB(b.x)], 1u);
        const unsigned gen = old / nloc;
        if (old + 1u == (gen + 1u) * nloc) {
            __builtin_amdgcn_fence(__ATOMIC_RELEASE, "agent");
            asm volatile("s_waitcnt vmcnt(0)" ::: "memory");
            const unsigned og = xb_add(&bar[XB_TOP], 1u);
            const unsigned tg = og / nx;
            if (og + 1u == (tg + 1u) * nx) xb_add(&bar[XB_TOPGEN], 1u);
            else XB_SPIN(xb_ld(&bar[XB_TOPGEN]) == tg, bar);
            __builtin_amdgcn_fence(__ATOMIC_ACQUIRE, "agent");
            xb_add(&bar[XB_XGEN(b.x)], 1u);
            asm volatile("s_waitcnt vmcnt(0)" ::: "memory");
        } else {
            XB_SPIN(xb_ld(&bar[XB_XGEN(b.x)]) == gen, bar);
            __builtin_amdgcn_fence(__ATOMIC_ACQUIRE, "agent");
            asm volatile("s_waitcnt vmcnt(0)" ::: "memory");
        }
    }
    __syncthreads();
}
#define SYNC() do { XcdBarrier xb_; xb_.bar = (unsigned*)get_args()->ws; xb_.x = xb_xcc_id(); xb_.st = (volatile LAS unsigned*)(lds + LDS_BYTES - 16); xcd_barrier(xb_, wv == 0 && lane_id() == 0); } while (0)
__global__ void __launch_bounds__(512, 2) fwd_kernel(Args a_unused) {
    extern __shared__ __attribute__((aligned(16))) unsigned char lds_raw[];
    LAS unsigned char* lds = (LAS unsigned char*)lds_raw;
    if (gridDim.x == 0x7fffffffu) cg::this_grid().sync();
    if (threadIdx.x < 4) ((volatile LAS unsigned*)(lds + LDS_BYTES - 16))[threadIdx.x] = 0u;
    __syncthreads();
    (void)xcd_barrier_post((unsigned*)get_args()->ws, (volatile LAS unsigned*)(lds + LDS_BYTES - 16));
    const int wv = __builtin_amdgcn_readfirstlane((int)threadIdx.x >> 6);
#define lane (lane_id())
#define gt ((int)(blockIdx.x * 512 + wv * 64 + lane_id()))
#define wave (wv)
#define G ((int)gridDim.x)
#define bx ((int)blockIdx.x)
#define nthreads (G * 512)
#define gw (bx * 8 + wave)
#define NGW (G * 8)

    {
        ArgsP ap = get_args();
        const float* w_in = ap->in[2]; const float* w_branch = ap->in[9]; const float* w_out = ap->in[10]; const float* w_up = ap->in[13]; const float* w_down = ap->in[16]; const float* w_pp = ap->in[19]; const float* w_pg = ap->in[20];
        LAS float* scr = (LAS float*)(lds + wave * 16384);
        constexpr int I_IN = 16 * 256, I_SQ = 16 * 32, I_UP = 16 * 176, I_DN = 44 * 32, I_PP = 4 * 32;
        constexpr int NITEMS = I_IN + 4 * I_SQ + I_UP + I_DN + I_PP;
        for (int it = gw; it < NITEMS; it += NGW) {
            int r = it;
            if (r < I_IN) { const int nb = r % 256, sec = nb >> 5;
                const int nsec = sec == 0 ? 4 : sec == 1 ? 5 : sec == 2 ? 0 : sec == 3 ? 1 : sec == 4 ? 2 : sec == 5 ? 3 : sec;
                p0_transpose_item(w_in, 1024, 8192, WSP(bf16_t, WS_WIN), (nsec - sec) * 1024, scr, r, lane); continue; } r -= I_IN;
            if (r < I_SQ) { p0_transpose_item(w_branch, 1024, 1024, WSP(bf16_t, WS_WA), 0, scr, r, lane); continue; } r -= I_SQ;
            if (r < I_SQ) { p0_transpose_item(w_branch + 1024 * 1024, 1024, 1024, WSP(bf16_t, WS_WB), 0, scr, r, lane); continue; } r -= I_SQ;
            if (r < I_SQ) { p0_transpose_item(w_out, 1024, 1024, WSP(bf16_t, WS_WOUT), 0, scr, r, lane); continue; } r -= I_SQ;
            if (r < I_SQ) { p0_transpose_item(w_pg, 1024, 1024, WSP(bf16_t, WS_WPG), 0, scr, r, lane); continue; } r -= I_SQ;
            if (r < I_UP) { const int n0 = 32 * (r % 176), isv = n0 >= 2816 ? 1 : 0, c0 = n0 - isv * 2816;
                p0_transpose_item(w_up, 1024, 5632, WSP(bf16_t, WS_WUP), (c0 >> 7) * 256 + isv * 128 + (c0 & 127) - n0, scr, r, lane); continue; } r -= I_UP;
            if (r < I_DN) { p0_transpose_item(w_down, 2816, 1024, WSP(bf16_t, WS_WDN), 0, scr, r, lane); continue; } r -= I_DN;
            p0_transpose_item(w_pp, 256, 1024, WSP(bf16_t, WS_WPP), 0, scr, r, lane);
        }
        cvt_f32_bf16(ap->in[0], WSP(bf16_t, WS_XBF), (size_t)M * D / 8, (size_t)gt, (size_t)nthreads);
        cvt_f32_bf16(ap->in[1], WSP(bf16_t, WS_PBF), (size_t)M * PLE / 8, (size_t)gt, (size_t)nthreads);
        if (gt < 1024) { const float* lbl = ap->in[7]; WSP(float, WS_LB)[gt] = sigmoidf_(lbl[gt] - lbl[1024 + gt]); }
    }
    SYNC();

    {
        ArgsP ap = get_args();
        pg8::Gemm g{WSP(bf16_t, WS_XBF), WSP(bf16_t, WS_WIN), M, 4096, 1024, 1024}; pg8::StaticOrder S; S.init(M, 4096, G, bx);
        pg8::EpiSec E{WSP(bf16_t, WS_Q), (size_t)32 * MiB, pg8::ACT_SILU | (pg8::ACT_LOGF << 4) | (pg8::ACT_NONE << 8) | (pg8::ACT_SILU << 12), 1024, 1024, WSP(float, WS_LB)};
        pg8::gemm_phase<pg8::EpiSec>(lds, g, S, E, wv);
    }
    SYNC();

    { ArgsP ap = get_args();
      for (int item = bx; item < 4096; item += 2 * G) { const int itemB = item + G < 4096 ? item + G : item;
        hgrn_pass_b2(lds, WSP(_Float16, WS_LOGF), WSP(bf16_t, WS_I), WSP(bf16_t, WS_U), WSP(float, WS_DTAB), item, itemB, wv); } }
    SYNC();
    { ArgsP ap = get_args(); hgrn_scan(WSP(bf16_t, WS_U), WSP(float, WS_DTAB), gt, nthreads); }
    SYNC();
    { ArgsP ap = get_args();
      for (int item = bx; item < 4096; item += G) hgrn_pass_ad(lds, WSP(bf16_t, WS_Q), WSP(_Float16, WS_LOGF), WSP(bf16_t, WS_I), WSP(bf16_t, WS_OG), WSP(bf16_t, WS_U), ap->in[8], item, wv); }
    SYNC();

    {
        ArgsP ap = get_args();
        pg8::Gemm g{WSP(bf16_t, WS_XBF), WSP(bf16_t, WS_WIN + 8 * MiB), M, 4096, 1024, 1024}; pg8::StaticOrder S; S.init(M, 4096, G, bx);
        pg8::EpiSec E{WSP(bf16_t, WS_LOGF), (size_t)32 * MiB, pg8::ACT_GELU | (pg8::ACT_GELU << 4) | (pg8::ACT_SIGM << 8) | (pg8::ACT_SIGM << 12), 1024, 1024, WSP(float, WS_LB)};
        pg8::gemm_phase<pg8::EpiSec>(lds, g, S, E, wv);
    }
    SYNC();

    { ArgsP ap = get_args();
      for (int nb = bx; nb < 256; nb += G) sgu_item(lds, WSP(bf16_t, WS_LOGF), WSP(bf16_t, WS_I), ap->in[3], ap->in[4], ap->in[5], ap->in[6], nb, wv); }
    SYNC();

    {
        ArgsP ap = get_args();
        pg8::StaticOrder S; S.init(M, 1024, G, bx);
        bf16_t* Tb = (bf16_t*)ap->out;
        { pg8::Gemm g{WSP(bf16_t, WS_LOGF), WSP(bf16_t, WS_WA), M, 1024, 1024, 1024}; pg8::EpiF32<pg8::MODE_T> E{nullptr, nullptr, WSP(bf16_t, WS_OG), nullptr, 0, Tb, 1024}; pg8::gemm_phase<pg8::EpiF32<pg8::MODE_T>>(lds, g, S, E, wv); }
        { pg8::Gemm g{WSP(bf16_t, WS_Q), WSP(bf16_t, WS_WB), M, 1024, 1024, 1024}; pg8::EpiF32<pg8::MODE_M> E{nullptr, nullptr, WSP(bf16_t, WS_U), Tb, 1024, WSP(bf16_t, WS_XBF), 1024}; pg8::gemm_phase<pg8::EpiF32<pg8::MODE_M>>(lds, g, S, E, wv); }
    }
    SYNC();

    {
        ArgsP ap = get_args();
        pg8::StaticOrder S; S.init(M, 1024, G, bx);
        pg8::Gemm g{WSP(bf16_t, WS_XBF), WSP(bf16_t, WS_WOUT), M, 1024, 1024, 1024}; pg8::EpiF32<pg8::MODE_Z> E{nullptr, ap->in[0], nullptr, nullptr, 0, (bf16_t*)ap->out, 1024}; pg8::gemm_phase<pg8::EpiF32<pg8::MODE_Z>>(lds, g, S, E, wv);
    }
    SYNC();

    { ArgsP ap = get_args(); const bf16_t* Zb = (const bf16_t*)ap->out; bf16_t* X1 = WSP(bf16_t, WS_XBF); const float* g1 = ap->in[11]; const float* b1 = ap->in[12];
      for (int m = 2 * gw; m < M; m += 2 * NGW) ln1_rows_bf16(Zb + (size_t)m * 1024, Zb + (size_t)(m + 1) * 1024, X1 + (size_t)m * 1024, X1 + (size_t)(m + 1) * 1024, g1, b1, lane); }
    SYNC();

    {
        ArgsP ap = get_args();
        pg8::Gemm g{WSP(bf16_t, WS_XBF), WSP(bf16_t, WS_WUP), M, 5632, 1024, 1024}; pg8::StaticOrder S; S.init(M, 5632, G, bx);
        pg8::EpiConv E{WSP(bf16_t, WS_ACT), ap->in[14], ap->in[15], WSP(float, WS_GL), WSP(float, WS_GF), WSP(float, WS_VF), (LAS float*)(lds + 131072)};
        pg8::gemm_phase<pg8::EpiConv>(lds, g, S, E, wv);
    }
    SYNC();

    {
        ArgsP ap = get_args();
        conv_fixup(WSP(bf16_t, WS_ACT), WSP(float, WS_GL), WSP(float, WS_GF), WSP(float, WS_VF), ap->in[14], ap->in[15], gt, nthreads);
        pg8::StaticOrder S; S.init(M, 1024, G, bx);
        bf16_t* E1 = WSP(bf16_t, WS_E1);
        { pg8::Gemm g{WSP(bf16_t, WS_PBF), WSP(bf16_t, WS_WPP), M, 1024, 256, 256}; pg8::EpiF32<pg8::MODE_E> E{nullptr, nullptr, nullptr, nullptr, 0, E1, 1024}; pg8::gemm_phase<pg8::EpiF32<pg8::MODE_E>>(lds, g, S, E, wv); }
        { pg8::Gemm g{WSP(bf16_t, WS_XBF), WSP(bf16_t, WS_WPG), M, 1024, 1024, 1024}; pg8::EpiF32<pg8::MODE_PLE> E{nullptr, nullptr, nullptr, E1, 1024, E1, 1024}; pg8::gemm_phase<pg8::EpiF32<pg8::MODE_PLE>>(lds, g, S, E, wv); }
    }
    SYNC();

    {
        ArgsP ap = get_args();
        pg8::StaticOrder S; S.init(M, 1024, G, bx);
        pg8::Gemm g{WSP(bf16_t, WS_ACT), WSP(bf16_t, WS_WDN), M, 1024, 2816, 2816}; pg8::EpiF32<pg8::MODE_FIN> E{ap->out, nullptr, WSP(bf16_t, WS_XBF), WSP(bf16_t, WS_E1), 1024, nullptr, 0}; pg8::gemm_phase<pg8::EpiF32<pg8::MODE_FIN>>(lds, g, S, E, wv);
    }
    SYNC();

    { ArgsP ap = get_args(); float* OUT = ap->out; const float* g2 = ap->in[17]; const float* b2 = ap->in[18];
      for (int m = 2 * gw; m < M; m += 2 * NGW) ln_row2<1>(OUT + (size_t)m * 1024, OUT + (size_t)(m + 1) * 1024, nullptr, nullptr, g2, b2, lane); }
}
#undef wave
#undef G
#undef bx
#undef nthreads
#undef gw
#undef NGW
#undef lane
#undef gt
extern "C" void kernel_launch(void* const* d_in, const int* in_sizes, int n_in, void* d_out, int out_size, void* d_ws, size_t ws_size, hipStream_t stream) {
    static int grid = 0;
    if (grid == 0) {
        if (n_in != 21 || out_size != M * D || ws_size < WS_NEED) { fprintf(stderr, "kernel_launch: unexpected shapes (n_in %d out %d ws %zu)\n", n_in, out_size, ws_size); grid = -1; return; }
        int dev = 0, cus = 0, per_cu = 0;
        hipGetDevice(&dev);
        hipDeviceGetAttribute(&cus, hipDeviceAttributeMultiprocessorCount, dev);
        hipFuncSetAttribute((const void*)fwd_kernel, hipFuncAttributeMaxDynamicSharedMemorySize, LDS_BYTES);
        hipOccupancyMaxActiveBlocksPerMultiprocessor(&per_cu, (const void*)fwd_kernel, 512, LDS_BYTES);
        if (per_cu < 1) per_cu = 1;
        grid = cus * per_cu;
        (void)hipGetLastError();
    }
    if (grid < 0) return;
    if (hipMemsetAsync(d_ws, 0, 16384, stream) != hipSuccess) { fprintf(stderr, "memset failed\n"); return; }
    Args a{};
    for (int i = 0; i < 21; ++i) a.in[i] = (const float*)d_in[i];
    a.out = (float*)d_out; a.ws = (unsigned char*)d_ws;
    void* args[] = {&a};
    hipError_t e = hipLaunchCooperativeKernel((const void*)fwd_kernel, dim3(grid), dim3(512), args, LDS_BYTES, stream);
    if (e != hipSuccess) fprintf(stderr, "cooperative launch failed: %s (grid %d)\n", hipGetErrorString(e), grid);
}
```
